# Optimizing an MI355X kernel written in HIP

```python
import math
import jax
import jax.numpy as jnp
from jax import lax
import numpy as np

D_MODEL = 2048
BATCH = 4
SEQ = 8192
DEPTH = 1

D_FF = 5632
EPS = 1e-6
SSM_WIDTH = 1024
SSM_GROUP = 16
SSM_GROUPS = SSM_WIDTH // SSM_GROUP
SSM_STATE = 64
DT_MIN = 1e-3
DT_MAX = 1e-1
N_HEADS = 16
N_KV = 4
HEADS_PER_KV = N_HEADS // N_KV
HEAD_DIM = 64
CMP_LEN = 32
CMP_STRIDE = 16
CMP_HID = 256
SEL_BLOCK = 64
N_SEL = 16
WINDOW = 512
Q_BLOCK = 128
SEL_FORCE = 1e4
NEG_INF = -1e30
N_BUCKETS = 32
MAX_DIST = 1024
Q_COLS = N_HEADS * HEAD_DIM
KV_COLS = N_KV * HEAD_DIM
NSA_GATE_COLS = 3 * N_HEADS
IN_COLS = SSM_WIDTH + Q_COLS + 6 * KV_COLS + NSA_GATE_COLS + 2 * D_MODEL

kernel_name = "hybrid_s5_nsa_macaron_block"


def _rmsnorm(x, g):
    xf = x.astype(jnp.float32)
    ms = jnp.mean(xf * xf, axis=-1, keepdims=True)
    return (xf * lax.rsqrt(ms + EPS)).astype(x.dtype) * g


def _swiglu(x, wg, wu, wd):
    return (jax.nn.silu(x @ wg) * (x @ wu)) @ wd


def _rel_bucket(dist):
    dist = jnp.maximum(dist, 0)
    max_exact = N_BUCKETS // 2
    d_f = jnp.maximum(dist, 1).astype(jnp.float32)
    large = max_exact + (jnp.log(d_f / max_exact) / math.log(MAX_DIST / max_exact)
                         * (N_BUCKETS - max_exact)).astype(jnp.int32)
    large = jnp.minimum(large, N_BUCKETS - 1)
    return jnp.where(dist < max_exact, dist, large)


def _masked_softmax(logits_f32, valid):
    return jax.nn.softmax(jnp.where(valid, logits_f32, NEG_INF), axis=-1)


def _ssm_combine(e1, e2):
    a1r, a1i, b1r, b1i = e1
    a2r, a2i, b2r, b2i = e2
    ar = a1r * a2r - a1i * a2i
    ai = a1r * a2i + a1i * a2r
    br = a2r * b1r - a2i * b1i + b2r
    bi = a2r * b1i + a2i * b1r + b2i
    return (ar, ai, br, bi)


def _s5(u, a_re, a_im, log_dt, b_re, b_im, c_re, c_im, d_skip):
    b_, t_, _ = u.shape
    ug = u.reshape(b_, t_, SSM_GROUPS, SSM_GROUP)
    dt = jnp.exp(log_dt)[:, None]
    lam_re = jnp.minimum(a_re, -1e-4)
    lam_im = a_im
    mag = jnp.exp(lam_re * dt)
    ab_re = mag * jnp.cos(lam_im * dt)
    ab_im = mag * jnp.sin(lam_im * dt)
    den = lam_re * lam_re + lam_im * lam_im
    n_re = ab_re - 1.0
    n_im = ab_im
    co_re = (n_re * lam_re + n_im * lam_im) / den
    co_im = (n_im * lam_re - n_re * lam_im) / den
    bb_re = co_re[..., None] * b_re - co_im[..., None] * b_im
    bb_im = co_re[..., None] * b_im + co_im[..., None] * b_re
    bu_re = jnp.einsum('btgc,gpc->tbgp', ug, bb_re)
    bu_im = jnp.einsum('btgc,gpc->tbgp', ug, bb_im)
    a_shape = (t_, 1, SSM_GROUPS, SSM_STATE)
    a_r = jnp.broadcast_to(ab_re[None, None], a_shape)
    a_i = jnp.broadcast_to(ab_im[None, None], a_shape)
    _, _, x_re, x_im = lax.associative_scan(_ssm_combine, (a_r, a_i, bu_re, bu_im), axis=0)
    y = (jnp.einsum('tbgp,gcp->btgc', x_re, c_re)
         - jnp.einsum('tbgp,gcp->btgc', x_im, c_im)
         + d_skip.reshape(SSM_GROUPS, SSM_GROUP) * ug)
    return y.reshape(b_, t_, SSM_WIDTH)


def _compress(raw, pos, w1, w2):
    b_, t_, _ = raw.shape
    n_sub = CMP_LEN // CMP_STRIDE
    nh = t_ // CMP_STRIDE
    nc = nh - n_sub + 1
    kk = raw.reshape(b_, nh, CMP_STRIDE, N_KV, HEAD_DIM)
    blocks = jnp.concatenate([kk[:, i:i + nc] for i in range(n_sub)], axis=2)
    blocks = blocks + pos[None, None, :, None, :]
    flat = blocks.transpose(0, 1, 3, 2, 4).reshape(b_, nc, N_KV, CMP_LEN * HEAD_DIM)
    return jax.nn.gelu(flat @ w1) @ w2


def _nsa(q, kc_raw, vc_raw, ks_raw, vs_raw, kw_raw, vw_raw, g_logits,
         cmp_pos, ck_w1, ck_w2, cv_w1, cv_w2, rel_bias):
    b_, t_, _ = q.shape
    G, HPG, dh = N_KV, HEADS_PER_KV, HEAD_DIM
    scale = dh ** -0.5
    f32 = jnp.float32
    qh = q.reshape(b_, t_, G, HPG, dh)
    gates = jax.nn.sigmoid(g_logits.reshape(b_, t_, G, HPG, 3))
    k_cmp = _compress(kc_raw, cmp_pos, ck_w1, ck_w2)
    v_cmp = _compress(vc_raw, cmp_pos, cv_w1, cv_w2)
    nc = k_cmp.shape[1]
    ns = t_ // SEL_BLOCK
    k_sel = min(N_SEL, ns)
    kblk = ks_raw.reshape(b_, ns, SEL_BLOCK, G, dh).transpose(0, 3, 1, 2, 4)
    vblk = vs_raw.reshape(b_, ns, SEL_BLOCK, G, dh).transpose(0, 3, 1, 2, 4)
    pad = ((0, 0), (WINDOW, 0), (0, 0), (0, 0))
    kwp = jnp.pad(kw_raw.reshape(b_, t_, G, dh), pad)
    vwp = jnp.pad(vw_raw.reshape(b_, t_, G, dh), pad)
    cmp_start = jnp.arange(nc) * CMP_STRIDE
    cmp_end = cmp_start + CMP_LEN - 1
    blk_ids = jnp.arange(ns)
    sel_start = blk_ids * SEL_BLOCK
    overlap = ((cmp_start[:, None] < sel_start[None, :] + SEL_BLOCK)
               & (cmp_start[:, None] + CMP_LEN > sel_start[None, :])).astype(f32)
    table_g = rel_bias.reshape(N_BUCKETS, G, HPG).transpose(1, 0, 2)
    bi = jnp.arange(b_)[:, None, None, None]
    gi = jnp.arange(G)[None, :, None, None]

    def dense_bias(dist):
        bias = rel_bias[_rel_bucket(dist)].reshape(dist.shape + (G, HPG))
        return bias.transpose(2, 3, 0, 1).astype(f32)

    def block(n):
        q0 = n * Q_BLOCK
        t = q0 + jnp.arange(Q_BLOCK)
        qb = lax.dynamic_slice_in_dim(qh, q0, Q_BLOCK, axis=1)
        gb = lax.dynamic_slice_in_dim(gates, q0, Q_BLOCK, axis=1)
        dist_c = t[:, None] - cmp_end[None, :]
        s_c = jnp.einsum('bqghd,bkgd->bghqk', qb, k_cmp).astype(f32) * scale + dense_bias(dist_c)
        p_c = _masked_softmax(s_c, dist_c >= 0) * (t >= CMP_LEN - 1).astype(f32)[:, None]
        o_c = jnp.einsum('bghqk,bkgd->bqghd', p_c.astype(v_cmp.dtype), v_cmp)
        imp = jnp.einsum('bghqk,kj->bgqj', p_c, overlap)
        valid_b = sel_start[None, :] <= t[:, None]
        cur = (t // SEL_BLOCK)[:, None]
        forced = valid_b & ((blk_ids[None, :] == 0) | (blk_ids[None, :] == cur)
                            | (blk_ids[None, :] == cur - 1))
        score = jnp.where(forced, SEL_FORCE, jnp.where(valid_b, imp, -SEL_FORCE))
        _, idx = lax.top_k(score, k_sel)
        ks_len = k_sel * SEL_BLOCK
        kg = kblk[bi, gi, idx].reshape(b_, G, Q_BLOCK, ks_len, dh)
        vg = vblk[bi, gi, idx].reshape(b_, G, Q_BLOCK, ks_len, dh)
        pos_s = (idx[..., None] * SEL_BLOCK + jnp.arange(SEL_BLOCK)).reshape(b_, G, Q_BLOCK, ks_len)
        dist_s = t[None, None, :, None] - pos_s
        bias_s = jnp.moveaxis(table_g[gi, _rel_bucket(dist_s)], -1, 2).astype(f32)
        s_s = jnp.einsum('bqghd,bgqkd->bghqk', qb, kg).astype(f32) * scale + bias_s
        p_s = _masked_softmax(s_s, (dist_s >= 0)[:, :, None])
        o_s = jnp.einsum('bghqk,bgqkd->bqghd', p_s.astype(vg.dtype), vg)
        kwb = lax.dynamic_slice_in_dim(kwp, q0, Q_BLOCK + WINDOW, axis=1)
        vwb = lax.dynamic_slice_in_dim(vwp, q0, Q_BLOCK + WINDOW, axis=1)
        pos_w = q0 - WINDOW + jnp.arange(Q_BLOCK + WINDOW)
        dist_w = t[:, None] - pos_w[None, :]
        valid_w = (dist_w >= 0) & (dist_w < WINDOW) & (pos_w >= 0)[None, :]
        s_w = jnp.einsum('bqghd,bkgd->bghqk', qb, kwb).astype(f32) * scale + dense_bias(dist_w)
        p_w = _masked_softmax(s_w, valid_w)
        o_w = jnp.einsum('bghqk,bkgd->bqghd', p_w.astype(vwb.dtype), vwb)
        return gb[..., 0:1] * o_c + gb[..., 1:2] * o_s + gb[..., 2:3] * o_w

    outs = lax.map(block, jnp.arange(t_ // Q_BLOCK))
    return jnp.moveaxis(outs, 0, 1).reshape(b_, t_, N_HEADS * dh)


def setup_inputs(seed: int = 0) -> dict:
    key = jax.random.key(seed)
    ks = iter(jax.random.split(key, 48))
    L = DEPTH

    def nrm(shape, scale):
        return jax.random.normal(next(ks), shape, jnp.float32) * scale

    def gain():
        return 1.0 + nrm((L, D_MODEL), 0.05)

    G, P, C = SSM_GROUPS, SSM_STATE, SSM_GROUP
    return {
        "x": nrm((BATCH, SEQ, D_MODEL), 1.0),
        "ffn1_pre_g": gain(),
        "ffn1_w_gate": nrm((L, D_MODEL, D_FF), D_MODEL ** -0.5),
        "ffn1_w_up": nrm((L, D_MODEL, D_FF), D_MODEL ** -0.5),
        "ffn1_w_down": nrm((L, D_FF, D_MODEL), D_FF ** -0.5),
        "ffn1_post_g": gain(),
        "mix_pre_g": gain(),
        "w_in": nrm((L, D_MODEL, IN_COLS), D_MODEL ** -0.5),
        "ssm_a_re": -0.5 + nrm((L, G, P), 0.01),
        "ssm_a_im": math.pi * jnp.arange(P, dtype=jnp.float32)[None, None, :] + nrm((L, G, P), 0.01),
        "ssm_log_dt": jax.random.uniform(next(ks), (L, G), jnp.float32,
                                         minval=math.log(DT_MIN), maxval=math.log(DT_MAX)),
        "ssm_b_re": nrm((L, G, P, C), (2 * C) ** -0.5),
        "ssm_b_im": nrm((L, G, P, C), (2 * C) ** -0.5),
        "ssm_c_re": nrm((L, G, C, P), (2 * P) ** -0.5),
        "ssm_c_im": nrm((L, G, C, P), (2 * P) ** -0.5),
        "ssm_d": nrm((L, SSM_WIDTH), 1.0),
        "ssm_glu_w1": nrm((L, SSM_WIDTH, D_MODEL), SSM_WIDTH ** -0.5),
        "ssm_glu_w2": nrm((L, SSM_WIDTH, D_MODEL), SSM_WIDTH ** -0.5),
        "cmp_pos": nrm((L, CMP_LEN, HEAD_DIM), 0.02),
        "cmp_k_w1": nrm((L, CMP_LEN * HEAD_DIM, CMP_HID), (CMP_LEN * HEAD_DIM) ** -0.5),
        "cmp_k_w2": nrm((L, CMP_HID, HEAD_DIM), CMP_HID ** -0.5),
        "cmp_v_w1": nrm((L, CMP_LEN * HEAD_DIM, CMP_HID), (CMP_LEN * HEAD_DIM) ** -0.5),
        "cmp_v_w2": nrm((L, CMP_HID, HEAD_DIM), CMP_HID ** -0.5),
        "nsa_w_o": nrm((L, N_HEADS * HEAD_DIM, D_MODEL), (N_HEADS * HEAD_DIM) ** -0.5),
        "w_out": nrm((L, D_MODEL, D_MODEL), D_MODEL ** -0.5),
        "mix_post_g": gain(),
        "ffn2_pre_g": gain(),
        "ffn2_w_gate": nrm((L, D_MODEL, D_FF), D_MODEL ** -0.5),
        "ffn2_w_up": nrm((L, D_MODEL, D_FF), D_MODEL ** -0.5),
        "ffn2_w_down": nrm((L, D_FF, D_MODEL), D_FF ** -0.5),
        "ffn2_post_g": gain(),
        "rel_bias": nrm((N_BUCKETS, N_HEADS), 0.5),
    }


def reference(x, ffn1_pre_g, ffn1_w_gate, ffn1_w_up, ffn1_w_down, ffn1_post_g,
              mix_pre_g, w_in, ssm_a_re, ssm_a_im, ssm_log_dt, ssm_b_re, ssm_b_im,
              ssm_c_re, ssm_c_im, ssm_d, ssm_glu_w1, ssm_glu_w2, cmp_pos,
              cmp_k_w1, cmp_k_w2, cmp_v_w1, cmp_v_w2, nsa_w_o, w_out, mix_post_g,
              ffn2_pre_g, ffn2_w_gate, ffn2_w_up, ffn2_w_down, ffn2_post_g, rel_bias):
    widths = [SSM_WIDTH, Q_COLS] + [KV_COLS] * 6 + [NSA_GATE_COLS, D_MODEL, D_MODEL]
    split_at = np.cumsum(widths)[:-1].tolist()
    h = x
    for l in range(DEPTH):
        f1 = _swiglu(_rmsnorm(h, ffn1_pre_g[l]), ffn1_w_gate[l], ffn1_w_up[l], ffn1_w_down[l])
        h = h + 0.5 * _rmsnorm(f1, ffn1_post_g[l])
        u = _rmsnorm(h, mix_pre_g[l])
        proj = u @ w_in[l]
        (u_ssm, q, kc, vc, ksl, vsl, kw, vw, g_nsa, g_a, g_b) = jnp.split(proj, split_at, axis=-1)
        y_ssm = jax.nn.gelu(_s5(u_ssm, ssm_a_re[l], ssm_a_im[l], ssm_log_dt[l], ssm_b_re[l],
                                ssm_b_im[l], ssm_c_re[l], ssm_c_im[l], ssm_d[l]))
        y_a = (y_ssm @ ssm_glu_w1[l]) * jax.nn.sigmoid(y_ssm @ ssm_glu_w2[l])
        o_nsa = _nsa(q, kc, vc, ksl, vsl, kw, vw, g_nsa, cmp_pos[l], cmp_k_w1[l], cmp_k_w2[l],
                     cmp_v_w1[l], cmp_v_w2[l], rel_bias)
        y_b = o_nsa @ nsa_w_o[l]
        mixed = (jax.nn.sigmoid(g_a) * y_a + jax.nn.sigmoid(g_b) * y_b) @ w_out[l]
        h = h + _rmsnorm(mixed, mix_post_g[l])
        f2 = _swiglu(_rmsnorm(h, ffn2_pre_g[l]), ffn2_w_gate[l], ffn2_w_up[l], ffn2_w_down[l])
        h = h + 0.5 * _rmsnorm(f2, ffn2_post_g[l])
    return h
```

```cpp
#include <hip/hip_runtime.h>
#include <hip/hip_cooperative_groups.h>
#include <cstdio>
#include <cstdint>
namespace cg = cooperative_groups;

#define LAS __attribute__((address_space(3)))
typedef unsigned short bf16_t;
typedef short bf16x8 __attribute__((ext_vector_type(8)));
typedef float f32x4 __attribute__((ext_vector_type(4)));
typedef unsigned u32x4 __attribute__((ext_vector_type(4)));
typedef unsigned u32x2 __attribute__((ext_vector_type(2)));

#ifndef PROGRAM_END
#define PROGRAM_END 99
#endif

constexpr int MTOK = 32768, DM = 2048, DFF = 5632, SEQ = 8192;
constexpr int NIN = 7936;
constexpr int LDS_BYTES = 147456;
constexpr int NTHREADS = 512;
constexpr float EPS = 1e-6f;

constexpr size_t SZ_WGU = (size_t)2 * DFF * DM * 2, SZ_WD = (size_t)DM * DFF * 2;
constexpr size_t WS_W1GU = 0;
constexpr size_t WS_W1D = WS_W1GU + SZ_WGU;
constexpr size_t WS_W2GU = WS_W1D + SZ_WD;
constexpr size_t WS_W2D = WS_W2GU + SZ_WGU;
constexpr size_t WS_WIN = WS_W2D + SZ_WD;
constexpr size_t WS_WGLU = WS_WIN + (size_t)NIN * DM * 2;
constexpr size_t WS_WO = WS_WGLU + (size_t)4096 * 1024 * 2;
constexpr size_t WS_WOUT = WS_WO + (size_t)2048 * 1024 * 2;
constexpr size_t WS_CKW1 = WS_WOUT + (size_t)2048 * 2048 * 2;
constexpr size_t WS_CVW1 = WS_CKW1 + (size_t)256 * 2048 * 2;
constexpr size_t WS_XN = WS_CVW1 + (size_t)256 * 2048 * 2;
constexpr size_t WS_ACT = WS_XN + (size_t)MTOK * DM * 2;
constexpr size_t WS_F = WS_ACT + (size_t)MTOK * DFF * 2;
constexpr size_t WS_KV = WS_F + (size_t)MTOK * DM * 2;
constexpr size_t SZ_KV1 = (size_t)MTOK * 256 * 2;
constexpr size_t WS_H1K = WS_KV + 6 * SZ_KV1 + 65536;
constexpr size_t WS_H1V = WS_H1K + (size_t)8192 * 256 * 2;
constexpr size_t WS_KCMP = WS_H1V + (size_t)8192 * 256 * 2;
constexpr size_t WS_VCMPT = WS_KCMP + (size_t)16 * 512 * 64 * 2;
constexpr size_t WS_GN = WS_VCMPT + (size_t)16 * 512 * 64 * 2;
constexpr size_t WS_S5A = WS_GN + (size_t)MTOK * 48 * 4;
constexpr size_t WS_S5B = WS_S5A + (size_t)64 * 64 * 2 * 4;
constexpr size_t WS_CB = WS_S5B + (size_t)64 * 64 * 32 * 4;
constexpr size_t WS_BAR = WS_CB + 2 * 256 * 4;
constexpr size_t WS_END = WS_BAR + 3456 * 4;

__device__ __forceinline__ unsigned f2bf(float f) { unsigned u = __builtin_bit_cast(unsigned, f); return (u + 0x7fffu + ((u >> 16) & 1u)) >> 16; }
__device__ __forceinline__ unsigned pk2(float lo, float hi) { unsigned r; asm volatile("v_cvt_pk_bf16_f32 %0, %1, %2" : "=v"(r) : "v"(lo), "v"(hi)); return r; }
__device__ __forceinline__ float bflo(unsigned u) { return __builtin_bit_cast(float, u << 16); }
__device__ __forceinline__ float bfhi(unsigned u) { return __builtin_bit_cast(float, u & 0xffff0000u); }
__device__ __forceinline__ float fexp(float x) { return __builtin_amdgcn_exp2f(x * 1.44269504089f); }
__device__ __forceinline__ float sigm(float x) { return __builtin_amdgcn_rcpf(1.f + fexp(-x)); }
__device__ __forceinline__ float silu(float x) { return x * sigm(x); }
__device__ __forceinline__ float gelu_tanh(float x) { return x * sigm(1.5957691216f * (x + 0.044715f * x * x * x)); }
__device__ __forceinline__ float wave_sum(float v) {
#pragma unroll
    for (int o = 1; o < 64; o <<= 1) v += __shfl_xor(v, o);
    return v;
}
#define LDS_WAIT() asm volatile("s_waitcnt lgkmcnt(0)" ::: "memory")
#define CBAR() asm volatile("" ::: "memory")
#define MFMA16(a, b, c) __builtin_amdgcn_mfma_f32_16x16x32_bf16(a, b, c, 0, 0, 0)
__device__ __forceinline__ bf16_t tobf(float x) { return (bf16_t)pk2(x, 0.f); }

namespace pg8 {
constexpr int BM = 256, BK = 64, HALF = 128, HTB = HALF * BK * 2, STAGE_BYTES = 8 * HTB, NXCD = 8, WGM = 8;
__host__ __device__ __forceinline__ int lds_byte(int r, int c) { const int st = (r >> 4) * 2 + (c >> 5), rr = r & 15, cc = c & 31, ob = rr * 64 + cc * 2; return st * 1024 + (ob ^ (((ob >> 9) & 1) << 5)); }
__host__ __device__ __forceinline__ void stage_rc(int b, int& R, int& C) { const int st = b / 1024, sb = b % 1024, swz = sb ^ (((sb >> 9) & 1) << 5); R = (st >> 1) * 16 + swz / 64; C = (st & 1) * 32 + (swz % 64) / 2; }
__host__ __device__ __forceinline__ int perm32(int rho) { const int n = rho >> 4, i = rho & 15; return 8 * (i >> 2) + 4 * n + (i & 3); }

struct Unit { int pm, pn; };
struct Gemm { const bf16_t* A; const bf16_t* Bt; int M, N, K, lda; };

struct StaticOrder {
    int nM, nN, nwg, G, c;
    __device__ void init(int M, int N, int G_, int c_) { nM = M / BM; nN = N / BM; nwg = nM * nN; G = G_; c = c_; }
    __device__ bool next(int i, Unit& u) const {
        const long L = (long)i * G + c; if (L >= nwg) return false;
        int wgid = (int)L; { const int q = nwg / NXCD, r = nwg % NXCD, xcd = wgid % NXCD, off = wgid / NXCD; wgid = (xcd < r ? xcd * (q + 1) : r * (q + 1) + (xcd - r) * q) + off; }
        const int nig = WGM * nN, gid = wgid / nig, fm = gid * WGM, gsz = (nM - fm) < WGM ? (nM - fm) : WGM;
        u.pm = fm + ((wgid % nig) % gsz); u.pn = (wgid % nig) / gsz; return true;
    }
};

template <bool LT, class Epi>
__device__ __forceinline__ void gemm_phase(LAS unsigned char* lds, const Gemm g, const StaticOrder& S, const Epi& E) {
    const int tid = LT ? ((const LAS int*)(lds + 145408))[threadIdx.x] : (int)threadIdx.x;
    const int wid = __builtin_amdgcn_readfirstlane(tid >> 6), lane = tid & 63, wr = wid >> 2, wc = wid & 3, fr = lane & 15, fq = lane >> 4;
    const int K = g.K, nt = K / BK, lda = g.lda;
    unsigned voffA[2], voffB[2];
#pragma unroll
    for (int i = 0; i < 2; ++i) { int R, C; stage_rc(tid * 16 + i * 8192, R, C); const int Rb = Epi::PERM ? ((R & ~31) + perm32(R & 31)) : R;
        voffA[i] = (unsigned)(R * lda + C) * 2u; voffB[i] = (unsigned)(Rb * K + C) * 2u; }
    const size_t kstep = (size_t)(BK * 2);
    const size_t hstepA = (size_t)HALF * lda * 2, hstepB = (size_t)HALF * K * 2;
    const size_t tstepA = 2 * hstepA, tstepB = 2 * hstepB;
    const unsigned ldsw = (unsigned)wid * 1024u;
    const int aoff = lds_byte(wr * 64 + fr, fq * 8), boff = lds_byte(wc * 32 + fr, fq * 8);
#define PG8_SA(b, h) (((b) * 2 + (h)) * HTB)
#define PG8_SB(b, h) ((4 + (b) * 2 + (h)) * HTB)
#define PG8_STAGE(bufoff, gbase, voff) do { _Pragma("unroll") for (int _i = 0; _i < 2; ++_i) \
        __builtin_amdgcn_global_load_lds((const unsigned*)((const char*)(gbase) + (voff)[_i]), (LAS unsigned*)(lds + (bufoff) + ldsw + _i * 8192), 16, 0, 0); } while (0)
#define PG8_LDA(dst, b, h) do { _Pragma("unroll") for (int m = 0; m < 4; ++m) _Pragma("unroll") for (int k = 0; k < 2; ++k) dst[m][k] = *(const LAS bf16x8*)(lds + PG8_SA(b, h) + aoff + m * 2048 + k * 1024); } while (0)
#define PG8_LDB(dst, b, h) do { _Pragma("unroll") for (int n = 0; n < 2; ++n) _Pragma("unroll") for (int k = 0; k < 2; ++k) dst[n][k] = *(const LAS bf16x8*)(lds + PG8_SB(b, h) + boff + n * 2048 + k * 1024); } while (0)
#define PG8_MMA(ai, bj, At, Bt) do { __builtin_amdgcn_s_setprio(1); _Pragma("unroll") for (int m = 0; m < 4; ++m) _Pragma("unroll") for (int n = 0; n < 2; ++n) _Pragma("unroll") for (int k = 0; k < 2; ++k) \
        acc[ai][bj][m][n] = __builtin_amdgcn_mfma_f32_16x16x32_bf16(Bt[n][k], At[m][k], acc[ai][bj][m][n], 0, 0, 0); __builtin_amdgcn_s_setprio(0); } while (0)
#define PG8_WAIT_V(n) asm volatile("s_waitcnt vmcnt(" #n ")" ::: "memory")
#define PG8_WAIT_L(n) asm volatile("s_waitcnt lgkmcnt(" #n ")" ::: "memory")
#define PG8_BAR __builtin_amdgcn_s_barrier()
#define PG8_SCHED __builtin_amdgcn_sched_barrier(0)
    Unit cur, nxt; int ui = 0;
    if (!S.next(0, cur)) return;
    f32x4 acc[2][2][4][2];
#pragma unroll
    for (int a = 0; a < 2; ++a)
#pragma unroll
        for (int b = 0; b < 2; ++b)
#pragma unroll
            for (int m = 0; m < 4; ++m)
#pragma unroll
                for (int n = 0; n < 2; ++n) acc[a][b][m][n] = (f32x4){0.f, 0.f, 0.f, 0.f};
    bf16x8 At[4][2], B0[2][2], B1[2][2];
    const char* cA = (const char*)g.A + (size_t)cur.pm * tstepA; const char* cB = (const char*)g.Bt + (size_t)cur.pn * tstepB;
    PG8_STAGE(PG8_SB(0, 0), cB, voffB); PG8_STAGE(PG8_SB(0, 1), cB + hstepB, voffB); PG8_STAGE(PG8_SA(0, 0), cA, voffA); PG8_STAGE(PG8_SA(0, 1), cA + hstepA, voffA);
    if (wr == 1) PG8_BAR;
    PG8_WAIT_V(2); PG8_BAR;
    PG8_STAGE(PG8_SB(1, 0), cB + kstep, voffB); PG8_STAGE(PG8_SA(1, 0), cA + kstep, voffA); PG8_STAGE(PG8_SB(1, 1), cB + hstepB + kstep, voffB);
    PG8_WAIT_V(6); PG8_BAR;
    for (;;) {
        const bool has_next = S.next(ui + 1, nxt);
        const char* nA = has_next ? (const char*)g.A + (size_t)nxt.pm * tstepA : cA; const char* nB = has_next ? (const char*)g.Bt + (size_t)nxt.pn * tstepB : cB;
        for (int t = 0; t < nt; t += 2) {
            const bool last = (t == nt - 2);
            const char* a1 = cA + (size_t)(t + 1) * kstep;
            const char* a2 = last ? nA : cA + (size_t)(t + 2) * kstep; const char* b2 = last ? nB : cB + (size_t)(t + 2) * kstep;
            const char* a3 = a2 + kstep; const char* b3 = b2 + kstep;
            PG8_LDB(B0, 0, 0); PG8_LDB(B1, 0, 1); PG8_SCHED; PG8_LDA(At, 0, 0); PG8_STAGE(PG8_SA(1, 1), a1 + hstepA, voffA);
            PG8_WAIT_V(8); PG8_WAIT_L(0); PG8_BAR; PG8_MMA(0, 0, At, B0); PG8_MMA(0, 1, At, B1); PG8_BAR; PG8_SCHED;
            PG8_LDA(At, 0, 1); PG8_STAGE(PG8_SB(0, 0), b2, voffB); PG8_STAGE(PG8_SB(0, 1), b2 + hstepB, voffB); PG8_STAGE(PG8_SA(0, 0), a2, voffA);
            PG8_WAIT_V(8); PG8_WAIT_L(0); PG8_BAR; PG8_MMA(1, 0, At, B0); PG8_MMA(1, 1, At, B1); PG8_BAR; PG8_SCHED;
            PG8_LDB(B0, 1, 0); PG8_LDB(B1, 1, 1); PG8_SCHED; PG8_LDA(At, 1, 0); PG8_STAGE(PG8_SA(0, 1), a2 + hstepA, voffA);
            PG8_WAIT_V(8); PG8_WAIT_L(0); PG8_BAR; PG8_MMA(0, 0, At, B0); PG8_MMA(0, 1, At, B1); PG8_BAR; PG8_SCHED;
            PG8_LDA(At, 1, 1); PG8_STAGE(PG8_SB(1, 0), b3, voffB); PG8_STAGE(PG8_SB(1, 1), b3 + hstepB, voffB); PG8_STAGE(PG8_SA(1, 0), a3, voffA);
            PG8_WAIT_V(8); PG8_WAIT_L(0); PG8_BAR; PG8_MMA(1, 0, At, B0); PG8_MMA(1, 1, At, B1); PG8_BAR; PG8_SCHED;
        }
        if (wr == 0) PG8_BAR;
        E(acc, cur, wr, wc, fr, fq);
        if (!has_next) break;
#pragma unroll
        for (int a = 0; a < 2; ++a)
#pragma unroll
            for (int b = 0; b < 2; ++b)
#pragma unroll
                for (int m = 0; m < 4; ++m)
#pragma unroll
                    for (int n = 0; n < 2; ++n) acc[a][b][m][n] = (f32x4){0.f, 0.f, 0.f, 0.f};
        cur = nxt; cA = nA; cB = nB; ++ui;
        if (wr == 1) PG8_BAR;
    }
    PG8_WAIT_V(0);
    PG8_BAR;
#undef PG8_SA
#undef PG8_SB
#undef PG8_STAGE
#undef PG8_LDA
#undef PG8_LDB
#undef PG8_MMA
#undef PG8_WAIT_V
#undef PG8_WAIT_L
#undef PG8_BAR
#undef PG8_SCHED
}
}
using pg8::Unit;
typedef const f32x4 (&AccRef)[2][2][4][2];

__device__ __forceinline__ u32x4 pack8(f32x4 a, f32x4 b) { u32x4 o; o.x = pk2(a[0], a[1]); o.y = pk2(a[2], a[3]); o.z = pk2(b[0], b[1]); o.w = pk2(b[2], b[3]); return o; }
__device__ __forceinline__ void unpack8(u32x4 v, f32x4& a, f32x4& b) { a[0] = bflo(v.x); a[1] = bfhi(v.x); a[2] = bflo(v.y); a[3] = bfhi(v.y); b[0] = bflo(v.z); b[1] = bfhi(v.z); b[2] = bflo(v.w); b[3] = bfhi(v.w); }

struct EpiStore {
    static constexpr bool PERM = true; bf16_t* O; int ldc;
    __device__ __forceinline__ void operator()(AccRef acc, const Unit& u, int wr, int wc, int fr, int fq) const {
        const int row0 = u.pm * 256 + wr * 64 + fr, col0 = u.pn * 256 + wc * 32 + 8 * fq;
#pragma unroll
        for (int ai = 0; ai < 2; ++ai)
#pragma unroll
            for (int m = 0; m < 4; ++m) { bf16_t* rowp = O + (size_t)(row0 + ai * 128 + m * 16) * ldc + col0;
#pragma unroll
                for (int bj = 0; bj < 2; ++bj) *(u32x4*)(rowp + bj * 128) = pack8(acc[ai][bj][m][0], acc[ai][bj][m][1]); }
    }
};
struct EpiSwiGLU {
    static constexpr bool PERM = true; bf16_t* O; int ldc;
    __device__ __forceinline__ void operator()(AccRef acc, const Unit& u, int wr, int wc, int fr, int fq) const {
        const int row0 = u.pm * 256 + wr * 64 + fr, col0 = u.pn * 128 + wc * 32 + 8 * fq;
#pragma unroll
        for (int ai = 0; ai < 2; ++ai)
#pragma unroll
            for (int m = 0; m < 4; ++m) { bf16_t* rowp = O + (size_t)(row0 + ai * 128 + m * 16) * ldc + col0;
                f32x4 a, b;
#pragma unroll
                for (int i = 0; i < 4; ++i) { a[i] = silu(acc[ai][0][m][0][i]) * acc[ai][1][m][0][i]; b[i] = silu(acc[ai][0][m][1][i]) * acc[ai][1][m][1][i]; }
                *(u32x4*)rowp = pack8(a, b); }
    }
};
struct EpiGLU {
    static constexpr bool PERM = true; bf16_t* O; const bf16_t* GA;
    __device__ __forceinline__ void operator()(AccRef acc, const Unit& u, int wr, int wc, int fr, int fq) const {
        const int row0 = u.pm * 256 + wr * 64 + fr, col0 = u.pn * 128 + wc * 32 + 8 * fq;
#pragma unroll
        for (int ai = 0; ai < 2; ++ai)
#pragma unroll
            for (int m = 0; m < 4; ++m) { const size_t off = (size_t)(row0 + ai * 128 + m * 16) * 2048 + col0;
                f32x4 g0, g1, a, b; unpack8(*(const u32x4*)(GA + off), g0, g1);
#pragma unroll
                for (int i = 0; i < 4; ++i) { a[i] = g0[i] * acc[ai][0][m][0][i] * sigm(acc[ai][1][m][0][i]); b[i] = g1[i] * acc[ai][0][m][1][i] * sigm(acc[ai][1][m][1][i]); }
                *(u32x4*)(O + off) = pack8(a, b); }
    }
};
struct EpiWo {
    static constexpr bool PERM = true; bf16_t* O; const bf16_t* GB;
    __device__ __forceinline__ void operator()(AccRef acc, const Unit& u, int wr, int wc, int fr, int fq) const {
        const int row0 = u.pm * 256 + wr * 64 + fr, col0 = u.pn * 256 + wc * 32 + 8 * fq;
#pragma unroll
        for (int ai = 0; ai < 2; ++ai)
#pragma unroll
            for (int m = 0; m < 4; ++m)
#pragma unroll
                for (int bj = 0; bj < 2; ++bj) { const size_t off = (size_t)(row0 + ai * 128 + m * 16) * 2048 + col0 + bj * 128;
                    f32x4 g0, g1, o0, o1, a, b; unpack8(*(const u32x4*)(GB + off), g0, g1); unpack8(*(const u32x4*)(O + off), o0, o1);
#pragma unroll
                    for (int i = 0; i < 4; ++i) { a[i] = o0[i] + g0[i] * acc[ai][bj][m][0][i]; b[i] = o1[i] + g1[i] * acc[ai][bj][m][1][i]; }
                    *(u32x4*)(O + off) = pack8(a, b); }
    }
};
struct EpiCmp {
    static constexpr bool PERM = true; bf16_t* O; const float* bias;
    __device__ __forceinline__ void operator()(AccRef acc, const Unit& u, int wr, int wc, int fr, int fq) const {
        const int row0 = u.pm * 256 + wr * 64 + fr, col0 = wc * 32 + 8 * fq;
#pragma unroll
        for (int bj = 0; bj < 2; ++bj) { const f32x4 b0 = *(const f32x4*)(bias + col0 + bj * 128), b1 = *(const f32x4*)(bias + col0 + bj * 128 + 4);
#pragma unroll
            for (int ai = 0; ai < 2; ++ai)
#pragma unroll
                for (int m = 0; m < 4; ++m) { f32x4 a, b;
#pragma unroll
                    for (int i = 0; i < 4; ++i) { a[i] = gelu_tanh(acc[ai][bj][m][0][i] + b0[i]); b[i] = gelu_tanh(acc[ai][bj][m][1][i] + b1[i]); }
                    *(u32x4*)(O + (size_t)(row0 + ai * 128 + m * 16) * 256 + col0 + bj * 128) = pack8(a, b); } }
    }
};
struct EpiIn {
    static constexpr bool PERM = true;
    bf16_t *USSM, *Q, *KV, *GA, *GB; float* GN;
    __device__ __forceinline__ void operator()(AccRef acc, const Unit& u, int wr, int wc, int fr, int fq) const {
        const int row0 = u.pm * 256 + wr * 64 + fr, cw = wc * 32 + 8 * fq; const int pn = u.pn;
        if (pn < 8) {
            bf16_t* base = pn < 4 ? USSM : Q; const float sc = pn < 4 ? 1.f : 0.18033688f  ; const int col0 = (pn & 3) * 256 + cw;
#pragma unroll
            for (int ai = 0; ai < 2; ++ai)
#pragma unroll
                for (int m = 0; m < 4; ++m) { bf16_t* rowp = base + (size_t)(row0 + ai * 128 + m * 16) * 1024 + col0;
#pragma unroll
                    for (int bj = 0; bj < 2; ++bj) *(u32x4*)(rowp + bj * 128) = pack8(acc[ai][bj][m][0] * sc, acc[ai][bj][m][1] * sc); }
        } else if (pn < 14) {
            const int kind = pn - 8; bf16_t* base = KV + (size_t)kind * ((size_t)MTOK * 256);
            const bool tr = (kind == 3) || (kind == 5);
#pragma unroll
            for (int ai = 0; ai < 2; ++ai)
#pragma unroll
                for (int m = 0; m < 4; ++m) { const int row = row0 + ai * 128 + m * 16, b = row >> 13, t = row & 8191;
#pragma unroll
                    for (int bj = 0; bj < 2; ++bj) { const int c = bj * 128 + cw, gg = c >> 6, d = c & 63;
                        if (!tr) *(u32x4*)(base + ((size_t)((b * 4 + gg) * SEQ + t)) * 64 + d) = pack8(acc[ai][bj][m][0], acc[ai][bj][m][1]);
                        else { bf16_t* p = base + ((size_t)((b * 4 + gg) * 64 + d)) * SEQ + t;
#pragma unroll
                            for (int i = 0; i < 4; ++i) { p[(size_t)i * SEQ] = (bf16_t)f2bf(acc[ai][bj][m][0][i]); p[(size_t)(4 + i) * SEQ] = (bf16_t)f2bf(acc[ai][bj][m][1][i]); } } } }
        } else if (pn < 30) {
            bf16_t* base = pn < 22 ? GA : GB; const int col0 = ((pn - 14) & 7) * 256 + cw;
#pragma unroll
            for (int ai = 0; ai < 2; ++ai)
#pragma unroll
                for (int m = 0; m < 4; ++m) { bf16_t* rowp = base + (size_t)(row0 + ai * 128 + m * 16) * 2048 + col0;
#pragma unroll
                    for (int bj = 0; bj < 2; ++bj) { f32x4 a, b;
#pragma unroll
                        for (int i = 0; i < 4; ++i) { a[i] = sigm(acc[ai][bj][m][0][i]); b[i] = sigm(acc[ai][bj][m][1][i]); }
                        *(u32x4*)(rowp + bj * 128) = pack8(a, b); } }
        } else {
            if (cw < 48) {
#pragma unroll
                for (int ai = 0; ai < 2; ++ai)
#pragma unroll
                    for (int m = 0; m < 4; ++m) { float* rowp = GN + (size_t)(row0 + ai * 128 + m * 16) * 48 + cw; f32x4 a, b;
#pragma unroll
                        for (int i = 0; i < 4; ++i) { a[i] = sigm(acc[ai][0][m][0][i]); b[i] = sigm(acc[ai][0][m][1][i]); }
                        *(f32x4*)rowp = a; *(f32x4*)(rowp + 4) = b; }
            }
        }
    }
};

__device__ __forceinline__ void tr_item(const float* __restrict__ W, int ldw, bf16_t* WT, int K, int k0, int src_col0, int nvalid, int dest_row0, LAS float* scr, int lane) {
    const int c = lane & 31;
    float wv[32];
#pragma unroll
    for (int i = 0; i < 32; ++i) { const int kk = 2 * i + (lane >> 5); wv[i] = (c < nvalid) ? W[(size_t)(k0 + kk) * ldw + src_col0 + c] : 0.f; }
#pragma unroll
    for (int i = 0; i < 32; ++i) { const int kk = 2 * i + (lane >> 5); scr[kk * 33 + c] = wv[i]; }
    LDS_WAIT();
    const int c8 = lane & 7;
#pragma unroll
    for (int j = 0; j < 4; ++j) { const int n = (lane >> 3) + 8 * j; const LAS float* s = scr + (8 * c8) * 33 + n;
        u32x4 o; o.x = pk2(s[0 * 33], s[1 * 33]); o.y = pk2(s[2 * 33], s[3 * 33]); o.z = pk2(s[4 * 33], s[5 * 33]); o.w = pk2(s[6 * 33], s[7 * 33]);
        *(u32x4*)(WT + (size_t)(dest_row0 + n) * K + k0 + 8 * c8) = o; }
    LDS_WAIT();
}
__device__ __forceinline__ void tr_job(const float* W, int ldw, int K, int nblk, bf16_t* WT, int item, int mode, LAS float* scr, int lane) {
    const int kb = item / nblk, nb = item - kb * nblk; int src = 32 * nb, dst = 32 * nb, nv = 32;
    if (mode == 1 || mode == 2) dst = (src >> 7) * 256 + (mode - 1) * 128 + (src & 127);
    else if (mode == 3) { if (dst < 3584) src = dst; else if (dst < 7680) src = dst + 48; else if (dst < 7712) src = 3584; else if (dst < 7744) { src = 3616; nv = 16; } else { src = 0; nv = 0; } }
    tr_item(W, ldw, WT, K, 64 * kb, src, nv, dst, scr, lane);
}

__device__ __forceinline__ void rowwise_row(const bf16_t* frow, const float* hin, float coef, const float* gpost, float* hout, const float* gpre, bf16_t* xn, int lane) {
    f32x4 f[4][2], h[4][2]; float ss = 0.f;
#pragma unroll
    for (int j = 0; j < 4; ++j) { unpack8(*(const u32x4*)(frow + 512 * j + 8 * lane), f[j][0], f[j][1]);
#pragma unroll
        for (int i = 0; i < 4; ++i) ss += f[j][0][i] * f[j][0][i] + f[j][1][i] * f[j][1][i]; }
    const float rs = coef * __frsqrt_rn(wave_sum(ss) * (1.f / DM) + EPS); float s2 = 0.f;
#pragma unroll
    for (int j = 0; j < 4; ++j)
#pragma unroll
        for (int q = 0; q < 2; ++q) { const int c = 512 * j + 8 * lane + 4 * q; const f32x4 hv = *(const f32x4*)(hin + c), gp = *(const f32x4*)(gpost + c);
            h[j][q] = hv + f[j][q] * rs * gp; *(f32x4*)(hout + c) = h[j][q];
#pragma unroll
            for (int i = 0; i < 4; ++i) s2 += h[j][q][i] * h[j][q][i]; }
    if (xn) { const float r2 = __frsqrt_rn(wave_sum(s2) * (1.f / DM) + EPS);
#pragma unroll
        for (int j = 0; j < 4; ++j) { const int c = 512 * j + 8 * lane; const f32x4 g0 = *(const f32x4*)(gpre + c), g1 = *(const f32x4*)(gpre + c + 4);
            *(u32x4*)(xn + c) = pack8(h[j][0] * r2 * g0, h[j][1] * r2 * g1); } }
}
__device__ __forceinline__ void norm_row(const float* xrow, const float* g, bf16_t* xn, int lane) {
    f32x4 h[4][2]; float s2 = 0.f;
#pragma unroll
    for (int j = 0; j < 4; ++j)
#pragma unroll
        for (int q = 0; q < 2; ++q) { h[j][q] = *(const f32x4*)(xrow + 512 * j + 8 * lane + 4 * q);
#pragma unroll
            for (int i = 0; i < 4; ++i) s2 += h[j][q][i] * h[j][q][i]; }
    const float r2 = __frsqrt_rn(wave_sum(s2) * (1.f / DM) + EPS);
#pragma unroll
    for (int j = 0; j < 4; ++j) { const int c = 512 * j + 8 * lane; const f32x4 g0 = *(const f32x4*)(g + c), g1 = *(const f32x4*)(g + c + 4);
        *(u32x4*)(xn + c) = pack8(h[j][0] * r2 * g0, h[j][1] * r2 * g1); }
}

struct Params { const float* in[32]; float* out; unsigned char* ws; };


__device__ __forceinline__ bf16x8 pack_bf8(const float* p, float sgn) {
    const f32x4 a = *(const f32x4*)p, b = *(const f32x4*)(p + 4); u32x4 o; o.x = pk2(sgn * a[0], sgn * a[1]); o.y = pk2(sgn * a[2], sgn * a[3]); o.z = pk2(sgn * b[0], sgn * b[1]); o.w = pk2(sgn * b[2], sgn * b[3]);
    return __builtin_bit_cast(bf16x8, o);
}
__device__ __forceinline__ void s5_phase(LAS unsigned char* lds, const bf16_t* USSM, const float* S5A, const float* S5B, const float* c_re, const float* c_im, const float* dskip,
                                         bf16_t* YSSM, int tid, int lane, int wave) {
    LAS float* carry = (LAS float*)lds;
    LAS unsigned char* wb = lds + 4096 + wave * 13312;
    LAS float* BU = (LAS float*)wb;
    LAS bf16_t* XB = (LAS bf16_t*)(wb + 8448);
    LAS bf16_t* UST = (LAS bf16_t*)(wb + 8448 + 4352);
    const int r16 = lane & 15, q4 = lane >> 4;
    const f32x4 z4 = {0.f, 0.f, 0.f, 0.f};
    const bf16x8 zf = {0, 0, 0, 0, 0, 0, 0, 0};
    for (int bg = blockIdx.x; bg < 256; bg += gridDim.x) {
        const int b = bg >> 6, g = bg & 63;
        __syncthreads();
        const float are = S5A[(g * 64 + lane) * 2], aim = S5A[(g * 64 + lane) * 2 + 1];
        bf16x8 bfr[8], cfr[4];
#pragma unroll
        for (int nt = 0; nt < 8; ++nt) { const int pp = nt * 16 + r16, p = pp & 63, im = pp >> 6; bfr[nt] = q4 < 2 ? pack_bf8(S5B + (size_t)(g * 64 + p) * 32 + im * 16 + q4 * 8, 1.f) : zf; }
#pragma unroll
        for (int ks = 0; ks < 4; ++ks) { const int pp = ks * 32 + q4 * 8, p = pp & 63, im = pp >> 6; cfr[ks] = pack_bf8((im ? c_im : c_re) + (size_t)(g * 16 + r16) * 64 + p, im ? -1.f : 1.f); }
        const float dsk = dskip[g * 16 + r16];
        const bf16_t* ub = USSM + ((size_t)(b * SEQ + wave * 1024)) * 1024 + g * 16;
        float xr = 0.f, xi = 0.f;
        for (int tb = 0; tb < 64; ++tb) {
            bf16x8 a = *(const bf16x8*)(ub + (size_t)(tb * 16 + r16) * 1024 + (q4 & 1) * 8); if (q4 >= 2) a = zf;
#pragma unroll
            for (int nt = 0; nt < 8; ++nt) { const f32x4 acc = MFMA16(a, bfr[nt], z4);
#pragma unroll
                for (int i = 0; i < 4; ++i) BU[(q4 * 4 + i) * 132 + nt * 16 + r16] = acc[i]; }
            LDS_WAIT();
#pragma unroll
            for (int t = 0; t < 16; ++t) { const float br = BU[t * 132 + lane], bi = BU[t * 132 + 64 + lane];
                const float nr = are * xr - aim * xi + br, ni = are * xi + aim * xr + bi; xr = nr; xi = ni; }
            LDS_WAIT();
        }
        carry[(wave * 64 + lane) * 2] = xr; carry[(wave * 64 + lane) * 2 + 1] = xi;
        __syncthreads();
        float pr = are, pi = aim;
#pragma unroll
        for (int k = 0; k < 10; ++k) { const float t2 = pr * pr - pi * pi; pi = 2.f * pr * pi; pr = t2; }
        xr = 0.f; xi = 0.f;
        for (int k = 0; k < wave; ++k) { const float er = carry[(k * 64 + lane) * 2], ei = carry[(k * 64 + lane) * 2 + 1]; const float nr = pr * xr - pi * xi + er, ni = pr * xi + pi * xr + ei; xr = nr; xi = ni; }
        for (int tb = 0; tb < 64; ++tb) {
            bf16x8 a = *(const bf16x8*)(ub + (size_t)(tb * 16 + r16) * 1024 + (q4 & 1) * 8); *(LAS bf16x8*)(UST + r16 * 16 + (q4 & 1) * 8) = a; if (q4 >= 2) a = zf;
#pragma unroll
            for (int nt = 0; nt < 8; ++nt) { const f32x4 acc = MFMA16(a, bfr[nt], z4);
#pragma unroll
                for (int i = 0; i < 4; ++i) BU[(q4 * 4 + i) * 132 + nt * 16 + r16] = acc[i]; }
            LDS_WAIT();
#pragma unroll
            for (int t = 0; t < 16; ++t) { const float br = BU[t * 132 + lane], bi = BU[t * 132 + 64 + lane];
                const float nr = are * xr - aim * xi + br, ni = are * xi + aim * xr + bi; xr = nr; xi = ni;
                XB[t * 136 + lane] = tobf(xr); XB[t * 136 + 64 + lane] = tobf(xi); }
            LDS_WAIT();
            f32x4 y = z4;
#pragma unroll
            for (int ks = 0; ks < 4; ++ks) y = MFMA16(*(const LAS bf16x8*)(XB + r16 * 136 + ks * 32 + q4 * 8), cfr[ks], y);
#pragma unroll
            for (int i = 0; i < 4; ++i) { const float u = bflo((unsigned)UST[(q4 * 4 + i) * 16 + r16]); BU[(q4 * 4 + i) * 16 + r16] = gelu_tanh(y[i] + dsk * u); }
            LDS_WAIT();
            { const f32x4 v = *(const LAS f32x4*)(BU + (lane >> 2) * 16 + (lane & 3) * 4); u32x2 o; o.x = pk2(v[0], v[1]); o.y = pk2(v[2], v[3]);
              *(u32x2*)(YSSM + ((size_t)(b * SEQ + wave * 1024 + tb * 16 + (lane >> 2))) * 1024 + g * 16 + (lane & 3) * 4) = o; }
            LDS_WAIT();
        }
    }
    __syncthreads();
}

__device__ __forceinline__ void cmp2_phase(LAS unsigned char* lds, const bf16_t* H1K, const bf16_t* H1V, const float* w2k, const float* w2v, bf16_t* KCMP, bf16_t* VCMPT, int tid) {
    LAS float* w2s = (LAS float*)lds;
    for (int i = tid; i < 32768; i += NTHREADS) w2s[i] = i < 16384 ? w2k[i] : w2v[i - 16384];
    __syncthreads();
    const int d = tid & 63, rsub = tid >> 6;
    for (int rg = blockIdx.x; rg < 1024; rg += gridDim.x) {
        const int row = rg * 8 + rsub; const bf16_t* hk = H1K + (size_t)row * 256; const bf16_t* hv = H1V + (size_t)row * 256;
        float ak = 0.f, av = 0.f;
        for (int n = 0; n < 256; n += 8) { f32x4 k0, k1, v0, v1; unpack8(*(const u32x4*)(hk + n), k0, k1); unpack8(*(const u32x4*)(hv + n), v0, v1);
#pragma unroll
            for (int j = 0; j < 4; ++j) { ak += k0[j] * w2s[(n + j) * 64 + d] + k1[j] * w2s[(n + 4 + j) * 64 + d]; av += v0[j] * w2s[16384 + (n + j) * 64 + d] + v1[j] * w2s[16384 + (n + 4 + j) * 64 + d]; } }
        const int bgi = row >> 9, i = row & 511; const bool ok = i < 511;
        KCMP[(size_t)row * 64 + d] = ok ? (bf16_t)f2bf(ak) : (bf16_t)0;
        VCMPT[((size_t)(bgi * 64 + d)) * 512 + i] = ok ? (bf16_t)f2bf(av) : (bf16_t)0;
    }
    __syncthreads();
}

__device__ __forceinline__ float red16(float v) { v += __shfl_xor(v, 1); v += __shfl_xor(v, 2); v += __shfl_xor(v, 4); v += __shfl_xor(v, 8); return v; }
__device__ __forceinline__ int clampd(int d) { return d < 0 ? 0 : (d > 1024 ? 1024 : d); }

__device__ __forceinline__ float ex2(float x) { return __builtin_amdgcn_exp2f(x); }
struct KFrag { bf16x8 k[4][2]; };
struct VFrag { bf16x8 v[2][4]; };
__device__ __forceinline__ void load_k(KFrag& f, const char* kb, unsigned koffB) {
#pragma unroll
    for (int cc = 0; cc < 4; ++cc) { f.k[cc][0] = *(const bf16x8*)(kb + cc * 2048 + koffB); f.k[cc][1] = *(const bf16x8*)(kb + cc * 2048 + 64 + koffB); }
}
__device__ __forceinline__ void load_v(VFrag& f, const char* vb, unsigned voffB, int vstride) {
#pragma unroll
    for (int ks = 0; ks < 2; ++ks)
#pragma unroll
        for (int nt = 0; nt < 4; ++nt) f.v[ks][nt] = *(const bf16x8*)(vb + (size_t)nt * 32 * vstride + ks * 64 + voffB);
}
__device__ __forceinline__ void pv_step(const VFrag& f, f32x4 (&o)[4], const LAS bf16_t* Pb, int r16, int q4) {
    CBAR();
#pragma unroll
    for (int ks = 0; ks < 2; ++ks) { const bf16x8 aP = *(const LAS bf16x8*)(Pb + r16 * 72 + ks * 32 + q4 * 8);
#pragma unroll
        for (int nt = 0; nt < 4; ++nt) o[nt] = MFMA16(aP, f.v[ks][nt], o[nt]); }
    CBAR();
}
__device__ __forceinline__ void qk_scores(const KFrag& f, const LAS bf16_t* qf, f32x4 (&sc)[4]) {
    const f32x4 z4 = {0.f, 0.f, 0.f, 0.f};
    const bf16x8 aq0 = *(const LAS bf16x8*)qf, aq1 = *(const LAS bf16x8*)(qf + 512);
#pragma unroll
    for (int cc = 0; cc < 4; ++cc) { sc[cc] = MFMA16(aq0, f.k[cc][0], z4); sc[cc] = MFMA16(aq1, f.k[cc][1], sc[cc]); }
}
template <int TT> __device__ __forceinline__ void sel_sm(const f32x4 (&sc)[4], int j, int tok, const LAS float* bt, LAS bf16_t* Pb, float& lsum, int r16, int q4) {
#pragma unroll
    for (int cc = 0; cc < 4; ++cc) {
        const int dist = tok - (64 * j + cc * 16 + r16);
        const float p = dist >= 0 ? ex2(sc[cc][TT] + bt[clampd(dist)]) : 0.f; lsum += p;
        Pb[(4 * q4 + TT) * 72 + cc * 16 + r16] = tobf(p);
    }
}
__device__ __forceinline__ void win_sm(const f32x4 (&sc)[4], int gr, int t0, const LAS float* bt, LAS bf16_t* Pb, float (&lw)[4], int r16, int q4) {
#pragma unroll
    for (int cc = 0; cc < 4; ++cc) {
        const int pos = gr * 64 + cc * 16 + r16;
#pragma unroll
        for (int i = 0; i < 4; ++i) { const int dist = t0 + i - pos; const float p = ((unsigned)dist < 512u) ? ex2(sc[cc][i] + bt[clampd(dist)]) : 0.f; lw[i] += p; Pb[(4 * q4 + i) * 72 + cc * 16 + r16] = tobf(p); }
    }
}
__device__ __forceinline__ void cmp_sm1(const f32x4 (&sc)[4], int gr, int t0, const LAS float* bt, float (&ls)[4], int r16) {
#pragma unroll
    for (int cc = 0; cc < 4; ++cc) {
        const int cend = (gr * 64 + cc * 16 + r16) * 16 + 31;
#pragma unroll
        for (int i = 0; i < 4; ++i) { const int dist = t0 + i - cend; ls[i] += dist >= 0 ? ex2(sc[cc][i] + bt[clampd(dist)]) : 0.f; }
    }
}
__device__ __forceinline__ void cmp_sm2(const f32x4 (&sc)[4], int gr, int t0, const LAS float* bt, const float (&inv)[4], LAS bf16_t* Pb, LAS float* psum, int r16, int q4) {
#pragma unroll
    for (int cc = 0; cc < 4; ++cc) {
        const int kk = gr * 64 + cc * 16 + r16, cend = kk * 16 + 31;
#pragma unroll
        for (int i = 0; i < 4; ++i) { const int dist = t0 + i - cend; float p = dist >= 0 ? ex2(sc[cc][i] + bt[clampd(dist)]) * inv[i] : 0.f;
            Pb[(4 * q4 + i) * 72 + cc * 16 + r16] = tobf(p); p += __shfl_xor(p, 16); p += __shfl_xor(p, 32); if (q4 == 0) psum[i * 512 + kk] = p; }
    }
}

__device__ __forceinline__ void nsa_quad_pre(int bg, int quad, const bf16_t* Q, const bf16_t* KV, const bf16_t* KCMP, const bf16_t* VCMPT, const float* GN, bf16_t* ONSA,
                                             const LAS float* btab, LAS bf16_t* Pb, LAS float* psum, LAS int* selq, LAS bf16_t* qfw, int lane) {
    const int r16 = lane & 15, q4 = lane >> 4, b = bg >> 2, g = bg & 3, t0 = quad * 4;
    const unsigned koff = (unsigned)(r16 * 64 + q4 * 8) * 2u, voffS = (unsigned)(r16 * SEQ + q4 * 8) * 2u, voffC = (unsigned)(r16 * 512 + q4 * 8) * 2u;
    const char* KWb = (const char*)(KV + 4 * (size_t)MTOK * 256 + (size_t)bg * SEQ * 64); const char* VWb = (const char*)(KV + 5 * (size_t)MTOK * 256 + (size_t)bg * 64 * SEQ);
    const char* KCb = (const char*)(KCMP + (size_t)bg * 512 * 64); const char* VCb = (const char*)(VCMPT + (size_t)bg * 64 * 512);
#define KP_C(i) KCb + (i) * 8192, koff
#define VP_C(i) VCb + (i) * 128, voffC, 512
#define KP_W(i) KWb + (i) * 8192, koff
#define VP_W(i) VWb + (i) * 128, voffS, SEQ
    const size_t qoff = (size_t)(b * SEQ + t0 + (r16 & 3)) * 1024 + (g * 4 + (r16 >> 2)) * 64 + q4 * 8;
    { const bf16x8 a0 = *(const bf16x8*)(Q + qoff), a1 = *(const bf16x8*)(Q + qoff + 32); *(LAS bf16x8*)(qfw + lane * 8) = a0; *(LAS bf16x8*)(qfw + 512 + lane * 8) = a1; }
    const LAS bf16_t* qf = qfw + lane * 8;
    const LAS float* bt = btab + q4 * 1028;
    const f32x4 z4 = {0.f, 0.f, 0.f, 0.f};
    KFrag KF; VFrag VF; f32x4 sc[4];
    const int w_lo = (t0 - 511 > 0 ? t0 - 511 : 0) >> 6, w_hi = t0 >> 6;
    f32x4 oc[4] = {z4, z4, z4, z4};
    const int tl = t0 + 3, nvmax = tl >= 31 ? ((tl - 31) >> 4) + 1 : 0, ngr = (nvmax + 63) >> 6;
    if (ngr > 0) {
        float ls[4] = {0.f, 0.f, 0.f, 0.f};
        load_k(KF, KP_C(0));
        for (int gr = 0; gr < ngr; ++gr) {
            qk_scores(KF, qf, sc);
            load_k(KF, KP_C(gr + 1 < ngr ? gr + 1 : 0));
            cmp_sm1(sc, gr, t0, bt, ls, r16);
        }
        load_v(VF, VP_C(0));
        float inv[4];
#pragma unroll
        for (int i = 0; i < 4; ++i) { const float l = red16(ls[i]); inv[i] = l > 0.f ? 1.f / l : 0.f; }
        for (int gr = 0; gr < ngr; ++gr) {
            const bool more = gr + 1 < ngr;
            qk_scores(KF, qf, sc);
            if (more) load_k(KF, KP_C(gr + 1));
            cmp_sm2(sc, gr, t0, bt, inv, Pb, psum, r16, q4);
            pv_step(VF, oc, Pb, r16, q4);
            if (more) load_v(VF, VP_C(gr + 1));
        }
    }
    CBAR();
#pragma unroll
    for (int tt = 0; tt < 4; ++tt) {
        const int tok = t0 + tt, cur = tok >> 6;
        if (cur < 16) { if (lane < 16) selq[tt * 16 + lane] = lane; }
        else {
            unsigned k0 = 0u, k1 = 0u;
            { const int j = lane; if (j >= 1 && j <= cur - 2) { const LAS float* ps = psum + tt * 512 + 4 * j - 1; const float v = ps[0] + ps[1] + ps[2] + ps[3] + ps[4]; k0 = (__builtin_bit_cast(unsigned, v) & ~127u) | (unsigned)(127 - j); } }
            { const int j = lane + 64; if (j <= cur - 2) { const LAS float* ps = psum + tt * 512 + 4 * j - 1; const float v = ps[0] + ps[1] + ps[2] + ps[3] + ps[4]; k1 = (__builtin_bit_cast(unsigned, v) & ~127u) | (unsigned)(127 - j); } }
            for (int it = 0; it < 13; ++it) {
                unsigned m = k0 > k1 ? k0 : k1;
#pragma unroll
                for (int off = 32; off >= 1; off >>= 1) { const unsigned o = (unsigned)__shfl_xor((int)m, off); m = o > m ? o : m; }
                if (k0 == m) k0 = 0u; if (k1 == m) k1 = 0u;
                if (lane == 0) selq[tt * 16 + it] = 127 - (int)(m & 127u);
            }
            if (lane == 0) { selq[tt * 16 + 13] = 0; selq[tt * 16 + 14] = cur - 1; selq[tt * 16 + 15] = cur; }
        }
    }
    CBAR();
#pragma unroll
    for (int tt = 0; tt < 4; ++tt) { const float gc = GN[(size_t)(b * SEQ + t0 + tt) * 48 + (g * 4 + q4) * 3];
        bf16_t* op = ONSA + (size_t)(b * SEQ + t0 + tt) * 1024 + (g * 4 + q4) * 64 + r16;
#pragma unroll
        for (int nt = 0; nt < 4; ++nt) op[nt * 16] = tobf(gc * oc[nt][tt]); }
#undef KP_C
#undef VP_C
#undef KP_W
#undef VP_W
}

template <int MODE>
__device__ __forceinline__ void nsa_block_loop(int bg, int qb, const bf16_t* Q, const bf16_t* KV, const float* GN, bf16_t* ONSA, const LAS float* btab, LAS bf16_t* Pb,
                                               const LAS int* selall, LAS unsigned* masks, LAS bf16_t* stage, int tid, int lane, int wave) {
    const int r16 = lane & 15, q4 = lane >> 4, b = bg >> 2, g = bg & 3;
    const bf16_t* Kt = KV + (MODE ? 4 : 2) * (size_t)MTOK * 256 + (size_t)bg * SEQ * 64; const bf16_t* Vt = KV + (MODE ? 5 : 3) * (size_t)MTOK * 256 + (size_t)bg * 64 * SEQ;
    const LAS float* bt = btab + q4 * 1028;
    const float bfar = bt[1024];
    const f32x4 z4 = {0.f, 0.f, 0.f, 0.f};
    const int j0 = MODE ? (qb - 8 > 0 ? qb - 8 : 0) : 0;
    if (MODE == 0 && tid < 256) { const int tok = tid >> 2, word = tid & 3; unsigned m = 0u;
        if (qb < 16) m = word == 0 ? ((2u << qb) - 1u) : 0u;
        else {
#pragma unroll
            for (int n = 0; n < 16; ++n) { const int j = selall[tok * 16 + n]; m |= ((j >> 5) == word) ? (1u << (j & 31)) : 0u; } }
        masks[tid] = m; }
    bf16x8 aq[2][2];
#pragma unroll
    for (int tile = 0; tile < 2; ++tile) { const int t0 = qb * 64 + wave * 8 + tile * 4;
        const size_t qoff = (size_t)(b * SEQ + t0 + (r16 & 3)) * 1024 + (g * 4 + (r16 >> 2)) * 64 + q4 * 8;
        aq[tile][0] = *(const bf16x8*)(Q + qoff); aq[tile][1] = *(const bf16x8*)(Q + qoff + 32); }
    f32x4 os[2][4]; float ls[2][4];
#pragma unroll
    for (int tile = 0; tile < 2; ++tile)
#pragma unroll
        for (int i = 0; i < 4; ++i) { os[tile][i] = z4; ls[tile][i] = 0.f; }
    const int srow = tid >> 3, sch = tid & 7, soff = srow * 72 + sch * 8;
    const unsigned kgo = (unsigned)(srow * 64 + sch * 8) * 2u, vgo = (unsigned)(srow * SEQ + sch * 8) * 2u;
#define NSA_LD1(jj) do { kr = *(const bf16x8*)((const char*)Kt + (size_t)(jj) * 8192 + kgo); vr = *(const bf16x8*)((const char*)Vt + (jj) * 128 + vgo); } while (0)
#define NSA_ST1(st_, half_) do { LAS bf16_t* nx_ = stage + (st_) * 18432 + (half_) * 9216 + soff; *(LAS bf16x8*)nx_ = kr; *(LAS bf16x8*)(nx_ + 4608) = vr; } while (0)
    bf16x8 kr, vr;
    NSA_LD1(j0); NSA_ST1(0, 0);
    if (j0 + 1 <= qb) { NSA_LD1(j0 + 1); NSA_ST1(0, 1); }
    __syncthreads();
    for (int jA = j0, pp = 0; jA <= qb; jA += 2, pp ^= 1) {
      for (int sub = 0; sub < 2; ++sub) {
        const int j = jA + sub; if (j > qb) break;
        const bool pre = j + 2 <= qb;
        if (pre) NSA_LD1(j + 2);
        const LAS bf16_t* Ks = stage + pp * 18432 + sub * 9216; const LAS bf16_t* Vs = Ks + 4608;
        const bool far = MODE == 0 && (qb - j >= 17);
#pragma unroll
        for (int tile = 0; tile < 2; ++tile) {
            const int tl0 = wave * 8 + tile * 4, t0 = qb * 64 + tl0;
            unsigned mb[4] = {1u, 1u, 1u, 1u};
            if (MODE == 0) {
#pragma unroll
                for (int i = 0; i < 4; ++i) mb[i] = (masks[(tl0 + i) * 4 + (j >> 5)] >> (j & 31)) & 1u; }
            if (MODE == 1 || __builtin_amdgcn_readfirstlane((int)(mb[0] | mb[1] | mb[2] | mb[3]))) {
                f32x4 sc[4];
                __builtin_amdgcn_s_setprio(1);
#pragma unroll
                for (int cc = 0; cc < 4; ++cc) { const LAS bf16_t* kp = Ks + (cc * 16 + r16) * 72 + q4 * 8;
                    sc[cc] = MFMA16(aq[tile][0], *(const LAS bf16x8*)kp, z4); sc[cc] = MFMA16(aq[tile][1], *(const LAS bf16x8*)(kp + 32), sc[cc]); }
                __builtin_amdgcn_s_setprio(0);
                if (far) {
#pragma unroll
                    for (int cc = 0; cc < 4; ++cc)
#pragma unroll
                        for (int i = 0; i < 4; ++i) { const float p = mb[i] ? ex2(sc[cc][i] + bfar) : 0.f; ls[tile][i] += p; Pb[(4 * q4 + i) * 72 + cc * 16 + r16] = tobf(p); }
                } else {
#pragma unroll
                    for (int cc = 0; cc < 4; ++cc) { const int pos = j * 64 + cc * 16 + r16;
#pragma unroll
                        for (int i = 0; i < 4; ++i) { const int dist = t0 + i - pos; const bool ok = MODE ? ((unsigned)dist < 512u) : (dist >= 0 && mb[i]);
                            const float p = ok ? ex2(sc[cc][i] + bt[clampd(dist)]) : 0.f; ls[tile][i] += p; Pb[(4 * q4 + i) * 72 + cc * 16 + r16] = tobf(p); } }
                }
                CBAR();
                __builtin_amdgcn_s_setprio(1);
#pragma unroll
                for (int ks = 0; ks < 2; ++ks) { const bf16x8 aP = *(const LAS bf16x8*)(Pb + r16 * 72 + ks * 32 + q4 * 8);
#pragma unroll
                    for (int nt = 0; nt < 4; ++nt) os[tile][nt] = MFMA16(aP, *(const LAS bf16x8*)(Vs + (nt * 16 + r16) * 72 + ks * 32 + q4 * 8), os[tile][nt]); }
                __builtin_amdgcn_s_setprio(0);
                CBAR();
            }
        }
        if (pre) NSA_ST1(pp ^ 1, sub);
      }
        __syncthreads();
    }
#undef NSA_LD1
#undef NSA_ST1
#pragma unroll
    for (int tile = 0; tile < 2; ++tile) { const int t0 = qb * 64 + wave * 8 + tile * 4;
#pragma unroll
        for (int tt = 0; tt < 4; ++tt) { const float gs = GN[(size_t)(b * SEQ + t0 + tt) * 48 + (g * 4 + q4) * 3 + (MODE ? 2 : 1)] / red16(ls[tile][tt]);
            bf16_t* op = ONSA + (size_t)(b * SEQ + t0 + tt) * 1024 + (g * 4 + q4) * 64 + r16;
#pragma unroll
            for (int nt = 0; nt < 4; ++nt) op[nt * 16] = tobf(bflo((unsigned)op[nt * 16]) + gs * os[tile][nt][tt]); } }
}

__device__ __forceinline__ int t5_bucket(int d) {
    if (d < 16) return d;
    if (d >= 1024) return 31;
    int k = 0;
    k += d >= 21; k += d >= 27; k += d >= 35; k += d >= 46; k += d >= 59; k += d >= 77; k += d >= 99; k += d >= 128;
    k += d >= 166; k += d >= 216; k += d >= 280; k += d >= 363; k += d >= 470; k += d >= 609; k += d >= 790;
    return 16 + k;
}
__device__ __forceinline__ void nsa_phase(LAS unsigned char* lds, const bf16_t* Q, const bf16_t* KV, const bf16_t* KCMP, const bf16_t* VCMPT, const float* GN, const float* rel_bias, bf16_t* ONSA,
                                          int tid, int lane, int wave) {
    LAS float* btab = (LAS float*)lds;
    LAS bf16_t* Pb = (LAS bf16_t*)(lds + 16448 + wave * 2304);
    LAS bf16_t* qfw = (LAS bf16_t*)(lds + 34880 + wave * 2048);
    LAS int* selall = (LAS int*)(lds + 51264);
    LAS unsigned* masks = (LAS unsigned*)(lds + 55360);
    LAS float* psum = (LAS float*)(lds + 56384 + wave * 8192);
    LAS bf16_t* stage = (LAS bf16_t*)(lds + 56384);
    for (int i = lane; i < 576; i += 64) ((LAS unsigned*)Pb)[i] = 0u;
    for (int vb = blockIdx.x; vb < 256; vb += gridDim.x) {
        const int xcd = vb & 7, idx = vb >> 3;
        for (int pass = 0; pass < 2; ++pass) {
            const int bg = xcd + 8 * pass, g = bg & 3;
            __syncthreads();
            for (int i2 = tid; i2 < 4 * 1025; i2 += NTHREADS) { const int hh = i2 / 1025, dd = i2 - hh * 1025; btab[hh * 1028 + dd] = 1.44269504089f * rel_bias[t5_bucket(dd) * 16 + g * 4 + hh]; }
            __syncthreads();
            for (int kk = 0; kk < 4; ++kk) {
                const int qb = (kk & 1) ? (32 * kk + 31 - idx) : (32 * kk + idx);
                nsa_quad_pre(bg, qb * 16 + wave * 2, Q, KV, KCMP, VCMPT, GN, ONSA, btab, Pb, psum, selall + (wave * 2) * 64, qfw, lane);
                nsa_quad_pre(bg, qb * 16 + wave * 2 + 1, Q, KV, KCMP, VCMPT, GN, ONSA, btab, Pb, psum, selall + (wave * 2 + 1) * 64, qfw, lane);
                __syncthreads();
                nsa_block_loop<0>(bg, qb, Q, KV, GN, ONSA, btab, Pb, selall, masks, stage, tid, lane, wave);
                nsa_block_loop<1>(bg, qb, Q, KV, GN, ONSA, btab, Pb, selall, masks, stage, tid, lane, wave);
            }
        }
    }
    __syncthreads();
}

#define XB_TMO      128
#define XB_XCNT(j)  (256  + 64 * (j))
#define XB_XSUB(j)  (1280 + 64 * (j))
#define XB_XGEN(j)  (2304 + 64 * (j))
#define XB_TOP      3328
#define XB_TOPGEN   3392
#define XCD_BAR_WORDS 3456
#define XB_SPIN_CAP (1u << 18)

__device__ __forceinline__ unsigned xb_ld(unsigned* p)              { return __hip_atomic_load(p, __ATOMIC_RELAXED, __HIP_MEMORY_SCOPE_AGENT); }
__device__ __forceinline__ unsigned xb_add(unsigned* p, unsigned v) { return __hip_atomic_fetch_add(p, v, __ATOMIC_RELAXED, __HIP_MEMORY_SCOPE_AGENT); }
__device__ __forceinline__ unsigned xb_xcc_id() { return (unsigned)__builtin_amdgcn_s_getreg((3 << 11) | 20) & 0xFu; }
#define XB_SPIN(cond, bar) do { unsigned _sp = 0; while (cond) { __builtin_amdgcn_s_sleep(1); \
    if ((++_sp & 255u) == 0u) { if (xb_ld(&(bar)[XB_TMO])) break; if (_sp > XB_SPIN_CAP) { atomicAdd(&(bar)[XB_TMO], 1u); break; } } } } while (0)

struct XcdBarrier {
    unsigned* bar; unsigned x;
    volatile LAS unsigned* st;
};

__device__ __forceinline__ XcdBarrier xcd_barrier_post(unsigned* bar, volatile LAS unsigned* st) {
    XcdBarrier b; b.bar = bar; b.x = xb_xcc_id(); b.st = st;
    if (threadIdx.x == 0) (void)xb_add(&bar[XB_XCNT(b.x)], 1u);
    return b;
}
__device__ __forceinline__ void xcd_barrier_complete(unsigned* bar, unsigned x, unsigned& nloc, unsigned& nx) {
    const unsigned G = gridDim.x * gridDim.y * gridDim.z;
    unsigned sum, cnt, mine, sp = 0u;
    for (;;) {
        sum = 0u; cnt = 0u; mine = 0u;
#pragma unroll
        for (unsigned j = 0; j < 16; ++j) { const unsigned c = xb_ld(&bar[XB_XCNT(j)]); sum += c; cnt += (c > 0u) ? 1u : 0u; mine = (j == x) ? c : mine; }
        if (sum == G) break;
        __builtin_amdgcn_s_sleep(1);
        if ((++sp & 255u) == 0u) { if (xb_ld(&bar[XB_TMO])) break; if (sp > XB_SPIN_CAP) { atomicAdd(&bar[XB_TMO], 1u); break; } }
    }
    nloc = mine > 0u ? mine : 1u; nx = cnt > 0u ? cnt : 1u;
}

__device__ __forceinline__ void xcd_barrier(const XcdBarrier& b) {
    asm volatile("s_waitcnt vmcnt(0)" ::: "memory");
    __syncthreads();
    if (threadIdx.x == 0) {
        unsigned* bar = b.bar;
        __builtin_amdgcn_s_waitcnt(0);
        unsigned nloc = b.st[0], nx = b.st[1];
        if (nloc == 0u) { xcd_barrier_complete(bar, b.x, nloc, nx); b.st[0] = nloc; b.st[1] = nx; }
        const unsigned old = xb_add(&bar[XB_XSUB(b.x)], 1u);
        const unsigned gen = old / nloc;
        if (old + 1u == (gen + 1u) * nloc) {
            __builtin_amdgcn_fence(__ATOMIC_RELEASE, "agent");
            asm volatile("s_waitcnt vmcnt(0)" ::: "memory");
            const unsigned og = xb_add(&bar[XB_TOP], 1u);
            const unsigned tg = og / nx;
            if (og + 1u == (tg + 1u) * nx) xb_add(&bar[XB_TOPGEN], 1u);
            else XB_SPIN(xb_ld(&bar[XB_TOPGEN]) == tg, bar);
            __builtin_amdgcn_fence(__ATOMIC_ACQUIRE, "agent");
            xb_add(&bar[XB_XGEN(b.x)], 1u);
            asm volatile("s_waitcnt vmcnt(0)" ::: "memory");
        } else {
            XB_SPIN(xb_ld(&bar[XB_XGEN(b.x)]) == gen, bar);
            __builtin_amdgcn_fence(__ATOMIC_ACQUIRE, "agent");
            asm volatile("s_waitcnt vmcnt(0)" ::: "memory");
        }
    }
    __syncthreads();
}


__global__ void __launch_bounds__(NTHREADS, 2) fwd_kernel(Params P) {
    extern __shared__ __attribute__((aligned(16))) unsigned char lds_raw[];
    LAS unsigned char* lds = (LAS unsigned char*)lds_raw;
    cg::grid_group grid = cg::this_grid();
    int tid = threadIdx.x, lane = tid & 63, wave = __builtin_amdgcn_readfirstlane(tid >> 6);
    const int G = gridDim.x, NGW = G * 8; int gw = blockIdx.x * 8 + wave;
#define REIDS() do { tid = threadIdx.x; asm volatile("" : "+v"(tid)); lane = tid & 63; wave = __builtin_amdgcn_readfirstlane(tid >> 6); gw = blockIdx.x * 8 + wave; } while (0)
    ((LAS int*)(lds + 145408))[tid] = tid; if (tid < 2) ((LAS unsigned*)(lds + 131072))[tid] = 0u; __syncthreads();
    const XcdBarrier xbar = xcd_barrier_post((unsigned*)(P.ws + WS_BAR), (volatile LAS unsigned*)(lds + 131072));
    unsigned char* ws = P.ws;
    bf16_t* W1GU = (bf16_t*)(ws + WS_W1GU); bf16_t* W1D = (bf16_t*)(ws + WS_W1D); bf16_t* W2GU = (bf16_t*)(ws + WS_W2GU); bf16_t* W2D = (bf16_t*)(ws + WS_W2D);
    bf16_t* WIN = (bf16_t*)(ws + WS_WIN); bf16_t* WGLU = (bf16_t*)(ws + WS_WGLU); bf16_t* WO = (bf16_t*)(ws + WS_WO); bf16_t* WOUT = (bf16_t*)(ws + WS_WOUT);
    bf16_t* CKW1 = (bf16_t*)(ws + WS_CKW1); bf16_t* CVW1 = (bf16_t*)(ws + WS_CVW1);
    bf16_t* XN = (bf16_t*)(ws + WS_XN); bf16_t* ACT = (bf16_t*)(ws + WS_ACT); bf16_t* FB = (bf16_t*)(ws + WS_F); bf16_t* KV = (bf16_t*)(ws + WS_KV);
    bf16_t* YSSM = XN; bf16_t* ONSA = XN + (size_t)MTOK * 1024;
    bf16_t* GA = ACT; bf16_t* GB = ACT + (size_t)MTOK * 2048; bf16_t* USSM = ACT + (size_t)MTOK * 4096; bf16_t* MIXED = ACT;
    bf16_t* QB = FB; bf16_t* MERGED = FB;
    bf16_t* H1K = (bf16_t*)(ws + WS_H1K); bf16_t* H1V = (bf16_t*)(ws + WS_H1V); bf16_t* KCMP = (bf16_t*)(ws + WS_KCMP); bf16_t* VCMPT = (bf16_t*)(ws + WS_VCMPT);
    float* GN = (float*)(ws + WS_GN); float* S5A = (float*)(ws + WS_S5A); float* S5B = (float*)(ws + WS_S5B); float* CB = (float*)(ws + WS_CB);
    const float* x = P.in[0]; float* out = P.out;

    {
        LAS float* scr = (LAS float*)(lds + wave * 16384);
        constexpr int I_FF = 5632, I_IN = 7936, I_GL = 1024, I_OUT = 2048, I_C = 256;
        constexpr int NITEMS = 6 * I_FF + I_IN + 3 * I_GL + I_OUT + 2 * I_C;
        for (int it = gw; it < NITEMS; it += NGW) {
            int r = it;
            if (r < I_FF) { tr_job(P.in[2], DFF, DM, 176, W1GU, r, 1, scr, lane); continue; } r -= I_FF;
            if (r < I_FF) { tr_job(P.in[3], DFF, DM, 176, W1GU, r, 2, scr, lane); continue; } r -= I_FF;
            if (r < I_FF) { tr_job(P.in[4], DM, DFF, 64, W1D, r, 0, scr, lane); continue; } r -= I_FF;
            if (r < I_FF) { tr_job(P.in[27], DFF, DM, 176, W2GU, r, 1, scr, lane); continue; } r -= I_FF;
            if (r < I_FF) { tr_job(P.in[28], DFF, DM, 176, W2GU, r, 2, scr, lane); continue; } r -= I_FF;
            if (r < I_FF) { tr_job(P.in[29], DM, DFF, 64, W2D, r, 0, scr, lane); continue; } r -= I_FF;
            if (r < I_IN) { tr_job(P.in[7], 7728, DM, 248, WIN, r, 3, scr, lane); continue; } r -= I_IN;
            if (r < I_GL) { tr_job(P.in[16], 2048, 1024, 64, WGLU, r, 1, scr, lane); continue; } r -= I_GL;
            if (r < I_GL) { tr_job(P.in[17], 2048, 1024, 64, WGLU, r, 2, scr, lane); continue; } r -= I_GL;
            if (r < I_GL) { tr_job(P.in[23], 2048, 1024, 64, WO, r, 0, scr, lane); continue; } r -= I_GL;
            if (r < I_OUT) { tr_job(P.in[24], 2048, 2048, 64, WOUT, r, 0, scr, lane); continue; } r -= I_OUT;
            if (r < I_C) { tr_job(P.in[19], 256, 2048, 8, CKW1, r, 0, scr, lane); continue; } r -= I_C;
            tr_job(P.in[21], 256, 2048, 8, CVW1, r, 0, scr, lane);
        }
        for (int m = gw; m < MTOK; m += NGW) norm_row(x + (size_t)m * DM, P.in[1], XN + (size_t)m * DM, lane);
        const int gid = blockIdx.x * NTHREADS + tid;
        if (gid < 4096) {
            const int g = gid >> 6;
            const float dt = expf(P.in[10][g]); const float lre = fminf(P.in[8][gid], -1e-4f), lim = P.in[9][gid];
            const float mag = expf(lre * dt);
            double th = (double)lim * (double)dt; th -= 6.283185307179586476925 * rint(th * 0.15915494309189533577); const double t2 = th * th;
            double sn = 1.0, cs = 1.0;
            { double term = 1.0; double s = 0.0, c = 0.0; for (int k = 0; k < 14; ++k) { c += term; term *= th / (double)(2 * k + 1); s += term; term *= -th / (double)(2 * k + 2); } sn = s; cs = c; (void)t2; }
            const float are = mag * (float)cs, aim = mag * (float)sn;
            const float den = lre * lre + lim * lim, nre = are - 1.f, nim = aim;
            const float cre = (nre * lre + nim * lim) / den, cim = (nim * lre - nre * lim) / den;
            S5A[gid * 2] = are; S5A[gid * 2 + 1] = aim;
            for (int c = 0; c < 16; ++c) { const float br = P.in[11][gid * 16 + c], bi = P.in[12][gid * 16 + c]; S5B[(size_t)gid * 32 + c] = cre * br - cim * bi; S5B[(size_t)gid * 32 + 16 + c] = cre * bi + cim * br; }
        }
    }
    grid.sync(); REIDS();
    { pg8::Gemm gm{XN, W1GU, MTOK, 2 * DFF, DM, DM}; pg8::StaticOrder S; S.init(MTOK, 2 * DFF, G, (int)blockIdx.x); EpiSwiGLU E{ACT, DFF}; pg8::gemm_phase<true>(lds, gm, S, E); }
    xcd_barrier(xbar); REIDS();
    { pg8::Gemm gm{ACT, W1D, MTOK, DM, DFF, DFF}; pg8::StaticOrder S; S.init(MTOK, DM, G, (int)blockIdx.x); EpiStore E{FB, DM}; pg8::gemm_phase<true>(lds, gm, S, E); }
    xcd_barrier(xbar); REIDS();
    for (int m = gw; m < MTOK; m += NGW) rowwise_row(FB + (size_t)m * DM, x + (size_t)m * DM, 0.5f, P.in[5], out + (size_t)m * DM, P.in[6], XN + (size_t)m * DM, lane);
    if (gw < 512) { const int n = gw & 255; const bf16_t* wrow = (gw >> 8 ? CVW1 : CKW1) + (size_t)n * 2048; float s = 0.f;
#pragma unroll
        for (int j = 0; j < 4; ++j) { const int c = 512 * j + 8 * lane; f32x4 w0, w1; unpack8(*(const u32x4*)(wrow + c), w0, w1); const f32x4 p0 = *(const f32x4*)(P.in[18] + c), p1 = *(const f32x4*)(P.in[18] + c + 4);
#pragma unroll
            for (int i = 0; i < 4; ++i) s += w0[i] * p0[i] + w1[i] * p1[i]; }
        s = wave_sum(s); if (lane == 0) CB[gw] = s; }
#if PROGRAM_END > 3
    xcd_barrier(xbar); REIDS();
    { pg8::Gemm gm{XN, WIN, MTOK, NIN, DM, DM}; pg8::StaticOrder S; S.init(MTOK, NIN, G, (int)blockIdx.x); EpiIn E{USSM, QB, KV, GA, GB, GN}; pg8::gemm_phase<false>(lds, gm, S, E); }
    xcd_barrier(xbar); REIDS();
    { pg8::Gemm gm{KV, CKW1, 8192, 256, 2048, 1024}; pg8::StaticOrder S; S.init(8192, 256, G, (int)blockIdx.x); EpiCmp E{H1K, CB}; pg8::gemm_phase<false>(lds, gm, S, E); }
    { pg8::Gemm gm{KV + (size_t)MTOK * 256, CVW1, 8192, 256, 2048, 1024}; pg8::StaticOrder S; S.init(8192, 256, G, (int)((blockIdx.x + G - 32) % G)); EpiCmp E{H1V, CB + 256}; pg8::gemm_phase<false>(lds, gm, S, E); }
    s5_phase(lds, USSM, S5A, S5B, P.in[13], P.in[14], P.in[15], YSSM, tid, lane, wave);
    xcd_barrier(xbar); REIDS();
    cmp2_phase(lds, H1K, H1V, P.in[20], P.in[22], KCMP, VCMPT, tid);
    xcd_barrier(xbar); REIDS();
    nsa_phase(lds, QB, KV, KCMP, VCMPT, GN, P.in[31], ONSA, tid, lane, wave);
    xcd_barrier(xbar); REIDS();
    { pg8::Gemm gm{YSSM, WGLU, MTOK, 4096, 1024, 1024}; pg8::StaticOrder S; S.init(MTOK, 4096, G, (int)blockIdx.x); EpiGLU E{MERGED, GA}; pg8::gemm_phase<true>(lds, gm, S, E); }
    xcd_barrier(xbar); REIDS();
    { pg8::Gemm gm{ONSA, WO, MTOK, 2048, 1024, 1024}; pg8::StaticOrder S; S.init(MTOK, 2048, G, (int)blockIdx.x); EpiWo E{MERGED, GB}; pg8::gemm_phase<true>(lds, gm, S, E); }
    xcd_barrier(xbar); REIDS();
    { pg8::Gemm gm{MERGED, WOUT, MTOK, 2048, 2048, 2048}; pg8::StaticOrder S; S.init(MTOK, 2048, G, (int)blockIdx.x); EpiStore E{MIXED, DM}; pg8::gemm_phase<true>(lds, gm, S, E); }
    xcd_barrier(xbar); REIDS();
    for (int m = gw; m < MTOK; m += NGW) rowwise_row(MIXED + (size_t)m * DM, out + (size_t)m * DM, 1.0f, P.in[25], out + (size_t)m * DM, P.in[26], XN + (size_t)m * DM, lane);
#endif
#if PROGRAM_END > 11
    xcd_barrier(xbar); REIDS();
    { pg8::Gemm gm{XN, W2GU, MTOK, 2 * DFF, DM, DM}; pg8::StaticOrder S; S.init(MTOK, 2 * DFF, G, (int)blockIdx.x); EpiSwiGLU E{ACT, DFF}; pg8::gemm_phase<true>(lds, gm, S, E); }
    xcd_barrier(xbar); REIDS();
    { pg8::Gemm gm{ACT, W2D, MTOK, DM, DFF, DFF}; pg8::StaticOrder S; S.init(MTOK, DM, G, (int)blockIdx.x); EpiStore E{FB, DM}; pg8::gemm_phase<true>(lds, gm, S, E); }
    xcd_barrier(xbar); REIDS();
    for (int m = gw; m < MTOK; m += NGW) rowwise_row(FB + (size_t)m * DM, out + (size_t)m * DM, 0.5f, P.in[30], out + (size_t)m * DM, nullptr, nullptr, lane);
#endif
}

extern "C" void kernel_launch(void* const* d_in, const int* in_sizes, int n_in, void* d_out, int out_size, void* d_ws, size_t ws_size, hipStream_t stream) {
    static int grid_blocks = 0;
    if (!grid_blocks) {
        int dev = 0, cus = 0, per_cu = 0;
        hipGetDevice(&dev);
        hipDeviceGetAttribute(&cus, hipDeviceAttributeMultiprocessorCount, dev);
        hipFuncSetAttribute((const void*)fwd_kernel, hipFuncAttributeMaxDynamicSharedMemorySize, LDS_BYTES);
        hipOccupancyMaxActiveBlocksPerMultiprocessor(&per_cu, (const void*)fwd_kernel, NTHREADS, LDS_BYTES);
        if (per_cu < 1) per_cu = 1;
        grid_blocks = cus * per_cu; if (grid_blocks > 256) grid_blocks = 256;
        if (ws_size < WS_END || n_in != 32) fprintf(stderr, "kernel_launch: unexpected ws_size %zu (need %zu) or n_in %d\n", ws_size, (size_t)WS_END, n_in);
    }
    hipMemsetAsync((char*)d_ws + WS_BAR, 0, 3456 * 4, stream);
    Params p{};
    for (int i = 0; i < 32; ++i) p.in[i] = (const float*)d_in[i];
    p.out = (float*)d_out; p.ws = (unsigned char*)d_ws;
    void* args[] = {&p};
    hipError_t e = hipLaunchCooperativeKernel((const void*)fwd_kernel, dim3(grid_blocks), dim3(NTHREADS), args, LDS_BYTES, stream);
    if (e != hipSuccess) fprintf(stderr, "cooperative launch failed: %s (grid %d)\n", hipGetErrorString(e), grid_blocks);
}
```

```cpp
#include <hip/hip_runtime.h>
#include <hip/hip_cooperative_groups.h>
#include <cstdio>
#include <cstdint>
namespace cg = cooperative_groups;

#define LAS __attribute__((address_space(3)))
typedef unsigned short bf16_t;
typedef short bf16x8 __attribute__((ext_vector_type(8)));
typedef float f32x4 __attribute__((ext_vector_type(4)));
typedef unsigned u32x4 __attribute__((ext_vector_type(4)));
typedef unsigned u32x2 __attribute__((ext_vector_type(2)));

#ifndef PROGRAM_END
#define PROGRAM_END 99
#endif

constexpr int MTOK = 32768, DM = 2048, DFF = 5632, SEQ = 8192;
constexpr int NIN = 7936;
constexpr int LDS_BYTES = 147456;
constexpr int NTHREADS = 512;
constexpr float EPS = 1e-6f;

constexpr size_t SZ_WGU = (size_t)2 * DFF * DM * 2, SZ_WD = (size_t)DM * DFF * 2;
constexpr size_t WS_W1GU = 0;
constexpr size_t WS_W1D = WS_W1GU + SZ_WGU;
constexpr size_t WS_W2GU = WS_W1D + SZ_WD;
constexpr size_t WS_W2D = WS_W2GU + SZ_WGU;
constexpr size_t WS_WIN = WS_W2D + SZ_WD;
constexpr size_t WS_WGLU = WS_WIN + (size_t)NIN * DM * 2;
constexpr size_t WS_WO = WS_WGLU + (size_t)4096 * 1024 * 2;
constexpr size_t WS_WOUT = WS_WO + (size_t)2048 * 1024 * 2;
constexpr size_t WS_CKW1 = WS_WOUT + (size_t)2048 * 2048 * 2;
constexpr size_t WS_CVW1 = WS_CKW1 + (size_t)256 * 2048 * 2;
constexpr size_t WS_XN = WS_CVW1 + (size_t)256 * 2048 * 2;
constexpr size_t WS_ACT = WS_XN + (size_t)MTOK * DM * 2;
constexpr size_t WS_F = WS_ACT + (size_t)MTOK * DFF * 2;
constexpr size_t WS_KV = WS_F + (size_t)MTOK * DM * 2;
constexpr size_t SZ_KV1 = (size_t)MTOK * 256 * 2;
constexpr size_t WS_H1K = WS_KV + 6 * SZ_KV1 + 65536;
constexpr size_t WS_H1V = WS_H1K + (size_t)8192 * 256 * 2;
constexpr size_t WS_KCMP = WS_H1V + (size_t)8192 * 256 * 2;
constexpr size_t WS_VCMPT = WS_KCMP + (size_t)16 * 512 * 64 * 2;
constexpr size_t WS_GN = WS_VCMPT + (size_t)16 * 512 * 64 * 2;
constexpr size_t WS_S5A = WS_GN + (size_t)MTOK * 48 * 4;
constexpr size_t WS_S5B = WS_S5A + (size_t)64 * 64 * 2 * 4;
constexpr size_t WS_CB = WS_S5B + (size_t)64 * 64 * 32 * 4;
constexpr size_t WS_BAR = WS_CB + 2 * 256 * 4;
constexpr size_t WS_END = WS_BAR + 3456 * 4;

__device__ __forceinline__ unsigned f2bf(float f) { unsigned u = __builtin_bit_cast(unsigned, f); return (u + 0x7fffu + ((u >> 16) & 1u)) >> 16; }
__device__ __forceinline__ unsigned pk2(float lo, float hi) { unsigned r; asm volatile("v_cvt_pk_bf16_f32 %0, %1, %2" : "=v"(r) : "v"(lo), "v"(hi)); return r; }
__device__ __forceinline__ float bflo(unsigned u) { return __builtin_bit_cast(float, u << 16); }
__device__ __forceinline__ float bfhi(unsigned u) { return __builtin_bit_cast(float, u & 0xffff0000u); }
__device__ __forceinline__ float fexp(float x) { return __builtin_amdgcn_exp2f(x * 1.44269504089f); }
__device__ __forceinline__ float sigm(float x) { return __builtin_amdgcn_rcpf(1.f + fexp(-x)); }
__device__ __forceinline__ float silu(float x) { return x * sigm(x); }
__device__ __forceinline__ float gelu_tanh(float x) { return x * sigm(1.5957691216f * (x + 0.044715f * x * x * x)); }
__device__ __forceinline__ float wave_sum(float v) {
#pragma unroll
    for (int o = 1; o < 64; o <<= 1) v += __shfl_xor(v, o);
    return v;
}
#define LDS_WAIT() asm volatile("s_waitcnt lgkmcnt(0)" ::: "memory")
#define CBAR() asm volatile("" ::: "memory")
#define MFMA16(a, b, c) __builtin_amdgcn_mfma_f32_16x16x32_bf16(a, b, c, 0, 0, 0)
__device__ __forceinline__ bf16_t tobf(float x) { return (bf16_t)pk2(x, 0.f); }

namespace pg8 {
constexpr int BM = 256, BK = 64, HALF = 128, HTB = HALF * BK * 2, STAGE_BYTES = 8 * HTB, NXCD = 8, WGM = 4  ;
__host__ __device__ __forceinline__ int lds_byte(int r, int c) { const int st = (r >> 4) * 2 + (c >> 5), rr = r & 15, cc = c & 31, ob = rr * 64 + cc * 2; return st * 1024 + (ob ^ (((ob >> 9) & 1) << 5)); }
__host__ __device__ __forceinline__ void stage_rc(int b, int& R, int& C) { const int st = b / 1024, sb = b % 1024, swz = sb ^ (((sb >> 9) & 1) << 5); R = (st >> 1) * 16 + swz / 64; C = (st & 1) * 32 + (swz % 64) / 2; }
__host__ __device__ __forceinline__ int perm32(int rho) { const int n = rho >> 4, i = rho & 15; return 8 * (i >> 2) + 4 * n + (i & 3); }

struct Unit { int pm, pn; };
struct Gemm { const bf16_t* A; const bf16_t* Bt; int M, N, K, lda; };

struct StaticOrder {
    int nM, nN, nwg, G, c;
    __device__ void init(int M, int N, int G_, int c_) { nM = M / BM; nN = N / BM; nwg = nM * nN; G = G_; c = c_; }
    __device__ bool next(int i, Unit& u) const {
        const long L = (long)i * G + c; if (L >= nwg) return false;
        int wgid = (int)L; { const int q = nwg / NXCD, r = nwg % NXCD, xcd = wgid % NXCD, off = wgid / NXCD; wgid = (xcd < r ? xcd * (q + 1) : r * (q + 1) + (xcd - r) * q) + off; }
        const int nig = WGM * nN, gid = wgid / nig, fm = gid * WGM, gsz = (nM - fm) < WGM ? (nM - fm) : WGM;
        u.pm = fm + ((wgid % nig) % gsz); u.pn = (wgid % nig) / gsz; return true;
    }
};

template <bool LT, class Epi>
__device__ __forceinline__ void gemm_phase(LAS unsigned char* lds, const Gemm g, const StaticOrder& S, const Epi& E) {
    const int tid = LT ? ((const LAS int*)(lds + 145408))[threadIdx.x] : (int)threadIdx.x;
    const int wid = __builtin_amdgcn_readfirstlane(tid >> 6), lane = tid & 63, wr = wid >> 2, wc = wid & 3, fr = lane & 15, fq = lane >> 4;
    const int K = g.K, nt = K / BK, lda = g.lda;
    unsigned voffA[2], voffB[2];
#pragma unroll
    for (int i = 0; i < 2; ++i) { int R, C; stage_rc(tid * 16 + i * 8192, R, C); const int Rb = Epi::PERM ? ((R & ~31) + perm32(R & 31)) : R;
        voffA[i] = (unsigned)(R * lda + C) * 2u; voffB[i] = (unsigned)(Rb * K + C) * 2u; }
    const size_t kstep = (size_t)(BK * 2);
    const size_t hstepA = (size_t)HALF * lda * 2, hstepB = (size_t)HALF * K * 2;
    const size_t tstepA = 2 * hstepA, tstepB = 2 * hstepB;
    const unsigned ldsw = (unsigned)wid * 1024u;
    const int aoff = lds_byte(wr * 64 + fr, fq * 8), boff = lds_byte(wc * 32 + fr, fq * 8);
#define PG8_SA(b, h) (((b) * 2 + (h)) * HTB)
#define PG8_SB(b, h) ((4 + (b) * 2 + (h)) * HTB)
#define PG8_STAGE(bufoff, gbase, voff) do { _Pragma("unroll") for (int _i = 0; _i < 2; ++_i) \
        __builtin_amdgcn_global_load_lds((const unsigned*)((const char*)(gbase) + (voff)[_i]), (LAS unsigned*)(lds + (bufoff) + ldsw + _i * 8192), 16, 0, 0); } while (0)
#define PG8_LDA(dst, b, h) do { _Pragma("unroll") for (int m = 0; m < 4; ++m) _Pragma("unroll") for (int k = 0; k < 2; ++k) dst[m][k] = *(const LAS bf16x8*)(lds + PG8_SA(b, h) + aoff + m * 2048 + k * 1024); } while (0)
#define PG8_LDB(dst, b, h) do { _Pragma("unroll") for (int n = 0; n < 2; ++n) _Pragma("unroll") for (int k = 0; k < 2; ++k) dst[n][k] = *(const LAS bf16x8*)(lds + PG8_SB(b, h) + boff + n * 2048 + k * 1024); } while (0)
#define PG8_MMA(ai, bj, At, Bt) do { __builtin_amdgcn_s_setprio(1); _Pragma("unroll") for (int m = 0; m < 4; ++m) _Pragma("unroll") for (int n = 0; n < 2; ++n) _Pragma("unroll") for (int k = 0; k < 2; ++k) \
        acc[ai][bj][m][n] = __builtin_amdgcn_mfma_f32_16x16x32_bf16(Bt[n][k], At[m][k], acc[ai][bj][m][n], 0, 0, 0); __builtin_amdgcn_s_setprio(0); } while (0)
#define PG8_WAIT_V(n) asm volatile("s_waitcnt vmcnt(" #n ")" ::: "memory")
#define PG8_WAIT_L(n) asm volatile("s_waitcnt lgkmcnt(" #n ")" ::: "memory")
#define PG8_BAR __builtin_amdgcn_s_barrier()
#define PG8_SCHED __builtin_amdgcn_sched_barrier(0)
    Unit cur, nxt; int ui = 0;
    if (!S.next(0, cur)) return;
    f32x4 acc[2][2][4][2];
#pragma unroll
    for (int a = 0; a < 2; ++a)
#pragma unroll
        for (int b = 0; b < 2; ++b)
#pragma unroll
            for (int m = 0; m < 4; ++m)
#pragma unroll
                for (int n = 0; n < 2; ++n) acc[a][b][m][n] = (f32x4){0.f, 0.f, 0.f, 0.f};
    bf16x8 At[4][2], B0[2][2], B1[2][2];
    const char* cA = (const char*)g.A + (size_t)cur.pm * tstepA; const char* cB = (const char*)g.Bt + (size_t)cur.pn * tstepB;
    PG8_STAGE(PG8_SB(0, 0), cB, voffB); PG8_STAGE(PG8_SB(0, 1), cB + hstepB, voffB); PG8_STAGE(PG8_SA(0, 0), cA, voffA); PG8_STAGE(PG8_SA(0, 1), cA + hstepA, voffA);
    if (wr == 1) PG8_BAR;
    PG8_WAIT_V(2); PG8_BAR;
    PG8_STAGE(PG8_SB(1, 0), cB + kstep, voffB); PG8_STAGE(PG8_SA(1, 0), cA + kstep, voffA); PG8_STAGE(PG8_SB(1, 1), cB + hstepB + kstep, voffB);
    PG8_WAIT_V(6); PG8_BAR;
    for (;;) {
        const bool has_next = S.next(ui + 1, nxt);
        const char* nA = has_next ? (const char*)g.A + (size_t)nxt.pm * tstepA : cA; const char* nB = has_next ? (const char*)g.Bt + (size_t)nxt.pn * tstepB : cB;
        for (int t = 0; t < nt; t += 2) {
            const bool last = (t == nt - 2);
            const char* a1 = cA + (size_t)(t + 1) * kstep;
            const char* a2 = last ? nA : cA + (size_t)(t + 2) * kstep; const char* b2 = last ? nB : cB + (size_t)(t + 2) * kstep;
            const char* a3 = a2 + kstep; const char* b3 = b2 + kstep;
            PG8_LDB(B0, 0, 0); PG8_LDB(B1, 0, 1); PG8_SCHED; PG8_LDA(At, 0, 0); PG8_STAGE(PG8_SA(1, 1), a1 + hstepA, voffA);
            PG8_WAIT_V(8); PG8_WAIT_L(0); PG8_BAR; PG8_MMA(0, 0, At, B0); PG8_MMA(0, 1, At, B1); PG8_BAR; PG8_SCHED;
            PG8_LDA(At, 0, 1); PG8_STAGE(PG8_SB(0, 0), b2, voffB); PG8_STAGE(PG8_SB(0, 1), b2 + hstepB, voffB); PG8_STAGE(PG8_SA(0, 0), a2, voffA);
            PG8_WAIT_V(8); PG8_WAIT_L(0); PG8_BAR; PG8_MMA(1, 0, At, B0); PG8_MMA(1, 1, At, B1); PG8_BAR; PG8_SCHED;
            PG8_LDB(B0, 1, 0); PG8_LDB(B1, 1, 1); PG8_SCHED; PG8_LDA(At, 1, 0); PG8_STAGE(PG8_SA(0, 1), a2 + hstepA, voffA);
            PG8_WAIT_V(8); PG8_WAIT_L(0); PG8_BAR; PG8_MMA(0, 0, At, B0); PG8_MMA(0, 1, At, B1); PG8_BAR; PG8_SCHED;
            PG8_LDA(At, 1, 1); PG8_STAGE(PG8_SB(1, 0), b3, voffB); PG8_STAGE(PG8_SB(1, 1), b3 + hstepB, voffB); PG8_STAGE(PG8_SA(1, 0), a3, voffA);
            PG8_WAIT_V(8); PG8_WAIT_L(0); PG8_BAR; PG8_MMA(1, 0, At, B0); PG8_MMA(1, 1, At, B1); PG8_BAR; PG8_SCHED;
        }
        if (wr == 0) PG8_BAR;
        E(acc, cur, wr, wc, fr, fq);
        if (!has_next) break;
#pragma unroll
        for (int a = 0; a < 2; ++a)
#pragma unroll
            for (int b = 0; b < 2; ++b)
#pragma unroll
                for (int m = 0; m < 4; ++m)
#pragma unroll
                    for (int n = 0; n < 2; ++n) acc[a][b][m][n] = (f32x4){0.f, 0.f, 0.f, 0.f};
        cur = nxt; cA = nA; cB = nB; ++ui;
        if (wr == 1) PG8_BAR;
    }
    PG8_WAIT_V(0);
    PG8_BAR;
#undef PG8_SA
#undef PG8_SB
#undef PG8_STAGE
#undef PG8_LDA
#undef PG8_LDB
#undef PG8_MMA
#undef PG8_WAIT_V
#undef PG8_WAIT_L
#undef PG8_BAR
#undef PG8_SCHED
}
}
using pg8::Unit;
typedef const f32x4 (&AccRef)[2][2][4][2];

__device__ __forceinline__ u32x4 pack8(f32x4 a, f32x4 b) { u32x4 o; o.x = pk2(a[0], a[1]); o.y = pk2(a[2], a[3]); o.z = pk2(b[0], b[1]); o.w = pk2(b[2], b[3]); return o; }
__device__ __forceinline__ void unpack8(u32x4 v, f32x4& a, f32x4& b) { a[0] = bflo(v.x); a[1] = bfhi(v.x); a[2] = bflo(v.y); a[3] = bfhi(v.y); b[0] = bflo(v.z); b[1] = bfhi(v.z); b[2] = bflo(v.w); b[3] = bfhi(v.w); }

struct EpiStore {
    static constexpr bool PERM = true; bf16_t* O; int ldc;
    __device__ __forceinline__ void operator()(AccRef acc, const Unit& u, int wr, int wc, int fr, int fq) const {
        const int row0 = u.pm * 256 + wr * 64 + fr, col0 = u.pn * 256 + wc * 32 + 8 * fq;
#pragma unroll
        for (int ai = 0; ai < 2; ++ai)
#pragma unroll
            for (int m = 0; m < 4; ++m) { bf16_t* rowp = O + (size_t)(row0 + ai * 128 + m * 16) * ldc + col0;
#pragma unroll
                for (int bj = 0; bj < 2; ++bj) *(u32x4*)(rowp + bj * 128) = pack8(acc[ai][bj][m][0], acc[ai][bj][m][1]); }
    }
};
struct EpiSwiGLU {
    static constexpr bool PERM = true; bf16_t* O; int ldc;
    __device__ __forceinline__ void operator()(AccRef acc, const Unit& u, int wr, int wc, int fr, int fq) const {
        const int row0 = u.pm * 256 + wr * 64 + fr, col0 = u.pn * 128 + wc * 32 + 8 * fq;
#pragma unroll
        for (int ai = 0; ai < 2; ++ai)
#pragma unroll
            for (int m = 0; m < 4; ++m) { bf16_t* rowp = O + (size_t)(row0 + ai * 128 + m * 16) * ldc + col0;
                f32x4 a, b;
#pragma unroll
                for (int i = 0; i < 4; ++i) { a[i] = silu(acc[ai][0][m][0][i]) * acc[ai][1][m][0][i]; b[i] = silu(acc[ai][0][m][1][i]) * acc[ai][1][m][1][i]; }
                *(u32x4*)rowp = pack8(a, b); }
    }
};
struct EpiGLU {
    static constexpr bool PERM = true; bf16_t* O; const bf16_t* GA;
    __device__ __forceinline__ void operator()(AccRef acc, const Unit& u, int wr, int wc, int fr, int fq) const {
        const int row0 = u.pm * 256 + wr * 64 + fr, col0 = u.pn * 128 + wc * 32 + 8 * fq;
#pragma unroll
        for (int ai = 0; ai < 2; ++ai)
#pragma unroll
            for (int m = 0; m < 4; ++m) { const size_t off = (size_t)(row0 + ai * 128 + m * 16) * 2048 + col0;
                f32x4 g0, g1, a, b; unpack8(*(const u32x4*)(GA + off), g0, g1);
#pragma unroll
                for (int i = 0; i < 4; ++i) { a[i] = g0[i] * acc[ai][0][m][0][i] * sigm(acc[ai][1][m][0][i]); b[i] = g1[i] * acc[ai][0][m][1][i] * sigm(acc[ai][1][m][1][i]); }
                *(u32x4*)(O + off) = pack8(a, b); }
    }
};
struct EpiWo {
    static constexpr bool PERM = true; bf16_t* O; const bf16_t* GB;
    __device__ __forceinline__ void operator()(AccRef acc, const Unit& u, int wr, int wc, int fr, int fq) const {
        const int row0 = u.pm * 256 + wr * 64 + fr, col0 = u.pn * 256 + wc * 32 + 8 * fq;
#pragma unroll
        for (int ai = 0; ai < 2; ++ai)
#pragma unroll
            for (int m = 0; m < 4; ++m)
#pragma unroll
                for (int bj = 0; bj < 2; ++bj) { const size_t off = (size_t)(row0 + ai * 128 + m * 16) * 2048 + col0 + bj * 128;
                    f32x4 g0, g1, o0, o1, a, b; unpack8(*(const u32x4*)(GB + off), g0, g1); unpack8(*(const u32x4*)(O + off), o0, o1);
#pragma unroll
                    for (int i = 0; i < 4; ++i) { a[i] = o0[i] + g0[i] * acc[ai][bj][m][0][i]; b[i] = o1[i] + g1[i] * acc[ai][bj][m][1][i]; }
                    *(u32x4*)(O + off) = pack8(a, b); }
    }
};
struct EpiCmp {
    static constexpr bool PERM = true; bf16_t* O; const float* bias;
    __device__ __forceinline__ void operator()(AccRef acc, const Unit& u, int wr, int wc, int fr, int fq) const {
        const int row0 = u.pm * 256 + wr * 64 + fr, col0 = wc * 32 + 8 * fq;
#pragma unroll
        for (int bj = 0; bj < 2; ++bj) { const f32x4 b0 = *(const f32x4*)(bias + col0 + bj * 128), b1 = *(const f32x4*)(bias + col0 + bj * 128 + 4);
#pragma unroll
            for (int ai = 0; ai < 2; ++ai)
#pragma unroll
                for (int m = 0; m < 4; ++m) { f32x4 a, b;
#pragma unroll
                    for (int i = 0; i < 4; ++i) { a[i] = gelu_tanh(acc[ai][bj][m][0][i] + b0[i]); b[i] = gelu_tanh(acc[ai][bj][m][1][i] + b1[i]); }
                    *(u32x4*)(O + (size_t)(row0 + ai * 128 + m * 16) * 256 + col0 + bj * 128) = pack8(a, b); } }
    }
};
struct EpiIn {
    static constexpr bool PERM = true;
    bf16_t *USSM, *Q, *KV, *GA, *GB; float* GN;
    __device__ __forceinline__ void operator()(AccRef acc, const Unit& u, int wr, int wc, int fr, int fq) const {
        const int row0 = u.pm * 256 + wr * 64 + fr, cw = wc * 32 + 8 * fq; const int pn = u.pn;
        if (pn < 8) {
            bf16_t* base = pn < 4 ? USSM : Q; const float sc = pn < 4 ? 1.f : 0.18033688f  ; const int col0 = (pn & 3) * 256 + cw;
#pragma unroll
            for (int ai = 0; ai < 2; ++ai)
#pragma unroll
                for (int m = 0; m < 4; ++m) { bf16_t* rowp = base + (size_t)(row0 + ai * 128 + m * 16) * 1024 + col0;
#pragma unroll
                    for (int bj = 0; bj < 2; ++bj) *(u32x4*)(rowp + bj * 128) = pack8(acc[ai][bj][m][0] * sc, acc[ai][bj][m][1] * sc); }
        } else if (pn < 14) {
            const int kind = pn - 8; bf16_t* base = KV + (size_t)kind * ((size_t)MTOK * 256);
            const bool tr = (kind == 3) || (kind == 5);
#pragma unroll
            for (int ai = 0; ai < 2; ++ai)
#pragma unroll
                for (int m = 0; m < 4; ++m) { const int row = row0 + ai * 128 + m * 16, b = row >> 13, t = row & 8191;
#pragma unroll
                    for (int bj = 0; bj < 2; ++bj) { const int c = bj * 128 + cw, gg = c >> 6, d = c & 63;
                        if (!tr) *(u32x4*)(base + ((size_t)((b * 4 + gg) * SEQ + t)) * 64 + d) = pack8(acc[ai][bj][m][0], acc[ai][bj][m][1]);
                        else { bf16_t* p = base + ((size_t)((b * 4 + gg) * 64 + d)) * SEQ + t;
#pragma unroll
                            for (int i = 0; i < 4; ++i) { p[(size_t)i * SEQ] = (bf16_t)f2bf(acc[ai][bj][m][0][i]); p[(size_t)(4 + i) * SEQ] = (bf16_t)f2bf(acc[ai][bj][m][1][i]); } } } }
        } else if (pn < 30) {
            bf16_t* base = pn < 22 ? GA : GB; const int col0 = ((pn - 14) & 7) * 256 + cw;
#pragma unroll
            for (int ai = 0; ai < 2; ++ai)
#pragma unroll
                for (int m = 0; m < 4; ++m) { bf16_t* rowp = base + (size_t)(row0 + ai * 128 + m * 16) * 2048 + col0;
#pragma unroll
                    for (int bj = 0; bj < 2; ++bj) { f32x4 a, b;
#pragma unroll
                        for (int i = 0; i < 4; ++i) { a[i] = sigm(acc[ai][bj][m][0][i]); b[i] = sigm(acc[ai][bj][m][1][i]); }
                        *(u32x4*)(rowp + bj * 128) = pack8(a, b); } }
        } else {
            if (cw < 48) {
#pragma unroll
                for (int ai = 0; ai < 2; ++ai)
#pragma unroll
                    for (int m = 0; m < 4; ++m) { float* rowp = GN + (size_t)(row0 + ai * 128 + m * 16) * 48 + cw; f32x4 a, b;
#pragma unroll
                        for (int i = 0; i < 4; ++i) { a[i] = sigm(acc[ai][0][m][0][i]); b[i] = sigm(acc[ai][0][m][1][i]); }
                        *(f32x4*)rowp = a; *(f32x4*)(rowp + 4) = b; }
            }
        }
    }
};

__device__ __forceinline__ void tr_item(const float* __restrict__ W, int ldw, bf16_t* WT, int K, int k0, int src_col0, int nvalid, int dest_row0, LAS float* scr, int lane) {
    const int c = lane & 31;
    float wv[32];
#pragma unroll
    for (int i = 0; i < 32; ++i) { const int kk = 2 * i + (lane >> 5); wv[i] = (c < nvalid) ? W[(size_t)(k0 + kk) * ldw + src_col0 + c] : 0.f; }
#pragma unroll
    for (int i = 0; i < 32; ++i) { const int kk = 2 * i + (lane >> 5); scr[kk * 33 + c] = wv[i]; }
    LDS_WAIT();
    const int c8 = lane & 7;
#pragma unroll
    for (int j = 0; j < 4; ++j) { const int n = (lane >> 3) + 8 * j; const LAS float* s = scr + (8 * c8) * 33 + n;
        u32x4 o; o.x = pk2(s[0 * 33], s[1 * 33]); o.y = pk2(s[2 * 33], s[3 * 33]); o.z = pk2(s[4 * 33], s[5 * 33]); o.w = pk2(s[6 * 33], s[7 * 33]);
        *(u32x4*)(WT + (size_t)(dest_row0 + n) * K + k0 + 8 * c8) = o; }
    LDS_WAIT();
}
__device__ __forceinline__ void tr_job(const float* W, int ldw, int K, int nblk, bf16_t* WT, int item, int mode, LAS float* scr, int lane) {
    const int kb = item / nblk, nb = item - kb * nblk; int src = 32 * nb, dst = 32 * nb, nv = 32;
    if (mode == 1 || mode == 2) dst = (src >> 7) * 256 + (mode - 1) * 128 + (src & 127);
    else if (mode == 3) { if (dst < 3584) src = dst; else if (dst < 7680) src = dst + 48; else if (dst < 7712) src = 3584; else if (dst < 7744) { src = 3616; nv = 16; } else { src = 0; nv = 0; } }
    tr_item(W, ldw, WT, K, 64 * kb, src, nv, dst, scr, lane);
}

__device__ __forceinline__ void rowwise_row(const bf16_t* frow, const float* hin, float coef, const float* gpost, float* hout, const float* gpre, bf16_t* xn, int lane) {
    f32x4 f[4][2], h[4][2]; float ss = 0.f;
#pragma unroll
    for (int j = 0; j < 4; ++j) { unpack8(*(const u32x4*)(frow + 512 * j + 8 * lane), f[j][0], f[j][1]);
#pragma unroll
        for (int i = 0; i < 4; ++i) ss += f[j][0][i] * f[j][0][i] + f[j][1][i] * f[j][1][i]; }
    const float rs = coef * __frsqrt_rn(wave_sum(ss) * (1.f / DM) + EPS); float s2 = 0.f;
#pragma unroll
    for (int j = 0; j < 4; ++j)
#pragma unroll
        for (int q = 0; q < 2; ++q) { const int c = 512 * j + 8 * lane + 4 * q; const f32x4 hv = *(const f32x4*)(hin + c), gp = *(const f32x4*)(gpost + c);
            h[j][q] = hv + f[j][q] * rs * gp; *(f32x4*)(hout + c) = h[j][q];
#pragma unroll
            for (int i = 0; i < 4; ++i) s2 += h[j][q][i] * h[j][q][i]; }
    if (xn) { const float r2 = __frsqrt_rn(wave_sum(s2) * (1.f / DM) + EPS);
#pragma unroll
        for (int j = 0; j < 4; ++j) { const int c = 512 * j + 8 * lane; const f32x4 g0 = *(const f32x4*)(gpre + c), g1 = *(const f32x4*)(gpre + c + 4);
            *(u32x4*)(xn + c) = pack8(h[j][0] * r2 * g0, h[j][1] * r2 * g1); } }
}
__device__ __forceinline__ void norm_row(const float* xrow, const float* g, bf16_t* xn, int lane) {
    f32x4 h[4][2]; float s2 = 0.f;
#pragma unroll
    for (int j = 0; j < 4; ++j)
#pragma unroll
        for (int q = 0; q < 2; ++q) { h[j][q] = *(const f32x4*)(xrow + 512 * j + 8 * lane + 4 * q);
#pragma unroll
            for (int i = 0; i < 4; ++i) s2 += h[j][q][i] * h[j][q][i]; }
    const float r2 = __frsqrt_rn(wave_sum(s2) * (1.f / DM) + EPS);
#pragma unroll
    for (int j = 0; j < 4; ++j) { const int c = 512 * j + 8 * lane; const f32x4 g0 = *(const f32x4*)(g + c), g1 = *(const f32x4*)(g + c + 4);
        *(u32x4*)(xn + c) = pack8(h[j][0] * r2 * g0, h[j][1] * r2 * g1); }
}

struct Params { const float* in[32]; float* out; unsigned char* ws; };


__device__ __forceinline__ bf16x8 pack_bf8(const float* p, float sgn) {
    const f32x4 a = *(const f32x4*)p, b = *(const f32x4*)(p + 4); u32x4 o; o.x = pk2(sgn * a[0], sgn * a[1]); o.y = pk2(sgn * a[2], sgn * a[3]); o.z = pk2(sgn * b[0], sgn * b[1]); o.w = pk2(sgn * b[2], sgn * b[3]);
    return __builtin_bit_cast(bf16x8, o);
}
__device__ __forceinline__ void s5_phase(LAS unsigned char* lds, const bf16_t* USSM, const float* S5A, const float* S5B, const float* c_re, const float* c_im, const float* dskip,
                                         bf16_t* YSSM, int tid, int lane, int wave) {
    LAS float* carry = (LAS float*)lds;
    LAS unsigned char* wb = lds + 4096 + wave * 13312;
    LAS float* BU = (LAS float*)wb;
    LAS bf16_t* XB = (LAS bf16_t*)(wb + 8448);
    LAS bf16_t* UST = (LAS bf16_t*)(wb + 8448 + 4352);
    const int r16 = lane & 15, q4 = lane >> 4;
    const f32x4 z4 = {0.f, 0.f, 0.f, 0.f};
    const bf16x8 zf = {0, 0, 0, 0, 0, 0, 0, 0};
    for (int bg = blockIdx.x; bg < 256; bg += gridDim.x) {
        const int b = bg >> 6, g = bg & 63;
        __syncthreads();
        const float are = S5A[(g * 64 + lane) * 2], aim = S5A[(g * 64 + lane) * 2 + 1];
        bf16x8 bfr[8], cfr[4];
#pragma unroll
        for (int nt = 0; nt < 8; ++nt) { const int pp = nt * 16 + r16, p = pp & 63, im = pp >> 6; bfr[nt] = q4 < 2 ? pack_bf8(S5B + (size_t)(g * 64 + p) * 32 + im * 16 + q4 * 8, 1.f) : zf; }
#pragma unroll
        for (int ks = 0; ks < 4; ++ks) { const int pp = ks * 32 + q4 * 8, p = pp & 63, im = pp >> 6; cfr[ks] = pack_bf8((im ? c_im : c_re) + (size_t)(g * 16 + r16) * 64 + p, im ? -1.f : 1.f); }
        const float dsk = dskip[g * 16 + r16];
        const bf16_t* ub = USSM + ((size_t)(b * SEQ + wave * 1024)) * 1024 + g * 16;
        float xr = 0.f, xi = 0.f;
        for (int tb = 0; tb < 64; ++tb) {
            bf16x8 a = *(const bf16x8*)(ub + (size_t)(tb * 16 + r16) * 1024 + (q4 & 1) * 8); if (q4 >= 2) a = zf;
#pragma unroll
            for (int nt = 0; nt < 8; ++nt) { const f32x4 acc = MFMA16(a, bfr[nt], z4);
#pragma unroll
                for (int i = 0; i < 4; ++i) BU[(q4 * 4 + i) * 132 + nt * 16 + r16] = acc[i]; }
            LDS_WAIT();
#pragma unroll
            for (int t = 0; t < 16; ++t) { const float br = BU[t * 132 + lane], bi = BU[t * 132 + 64 + lane];
                const float nr = are * xr - aim * xi + br, ni = are * xi + aim * xr + bi; xr = nr; xi = ni; }
            LDS_WAIT();
        }
        carry[(wave * 64 + lane) * 2] = xr; carry[(wave * 64 + lane) * 2 + 1] = xi;
        __syncthreads();
        float pr = are, pi = aim;
#pragma unroll
        for (int k = 0; k < 10; ++k) { const float t2 = pr * pr - pi * pi; pi = 2.f * pr * pi; pr = t2; }
        xr = 0.f; xi = 0.f;
        for (int k = 0; k < wave; ++k) { const float er = carry[(k * 64 + lane) * 2], ei = carry[(k * 64 + lane) * 2 + 1]; const float nr = pr * xr - pi * xi + er, ni = pr * xi + pi * xr + ei; xr = nr; xi = ni; }
        for (int tb = 0; tb < 64; ++tb) {
            bf16x8 a = *(const bf16x8*)(ub + (size_t)(tb * 16 + r16) * 1024 + (q4 & 1) * 8); *(LAS bf16x8*)(UST + r16 * 16 + (q4 & 1) * 8) = a; if (q4 >= 2) a = zf;
#pragma unroll
            for (int nt = 0; nt < 8; ++nt) { const f32x4 acc = MFMA16(a, bfr[nt], z4);
#pragma unroll
                for (int i = 0; i < 4; ++i) BU[(q4 * 4 + i) * 132 + nt * 16 + r16] = acc[i]; }
            LDS_WAIT();
#pragma unroll
            for (int t = 0; t < 16; ++t) { const float br = BU[t * 132 + lane], bi = BU[t * 132 + 64 + lane];
                const float nr = are * xr - aim * xi + br, ni = are * xi + aim * xr + bi; xr = nr; xi = ni;
                XB[t * 136 + lane] = tobf(xr); XB[t * 136 + 64 + lane] = tobf(xi); }
            LDS_WAIT();
            f32x4 y = z4;
#pragma unroll
            for (int ks = 0; ks < 4; ++ks) y = MFMA16(*(const LAS bf16x8*)(XB + r16 * 136 + ks * 32 + q4 * 8), cfr[ks], y);
#pragma unroll
            for (int i = 0; i < 4; ++i) { const float u = bflo((unsigned)UST[(q4 * 4 + i) * 16 + r16]); BU[(q4 * 4 + i) * 16 + r16] = gelu_tanh(y[i] + dsk * u); }
            LDS_WAIT();
            { const f32x4 v = *(const LAS f32x4*)(BU + (lane >> 2) * 16 + (lane & 3) * 4); u32x2 o; o.x = pk2(v[0], v[1]); o.y = pk2(v[2], v[3]);
              *(u32x2*)(YSSM + ((size_t)(b * SEQ + wave * 1024 + tb * 16 + (lane >> 2))) * 1024 + g * 16 + (lane & 3) * 4) = o; }
            LDS_WAIT();
        }
    }
    __syncthreads();
}

__device__ __forceinline__ void cmp2_phase(LAS unsigned char* lds, const bf16_t* H1K, const bf16_t* H1V, const float* w2k, const float* w2v, bf16_t* KCMP, bf16_t* VCMPT, int tid) {
    LAS float* w2s = (LAS float*)lds;
    for (int i = tid; i < 32768; i += NTHREADS) w2s[i] = i < 16384 ? w2k[i] : w2v[i - 16384];
    __syncthreads();
    const int d = tid & 63, rsub = tid >> 6;
    for (int rg = blockIdx.x; rg < 1024; rg += gridDim.x) {
        const int row = rg * 8 + rsub; const bf16_t* hk = H1K + (size_t)row * 256; const bf16_t* hv = H1V + (size_t)row * 256;
        float ak = 0.f, av = 0.f;
        for (int n = 0; n < 256; n += 8) { f32x4 k0, k1, v0, v1; unpack8(*(const u32x4*)(hk + n), k0, k1); unpack8(*(const u32x4*)(hv + n), v0, v1);
#pragma unroll
            for (int j = 0; j < 4; ++j) { ak += k0[j] * w2s[(n + j) * 64 + d] + k1[j] * w2s[(n + 4 + j) * 64 + d]; av += v0[j] * w2s[16384 + (n + j) * 64 + d] + v1[j] * w2s[16384 + (n + 4 + j) * 64 + d]; } }
        const int bgi = row >> 9, i = row & 511; const bool ok = i < 511;
        KCMP[(size_t)row * 64 + d] = ok ? (bf16_t)f2bf(ak) : (bf16_t)0;
        VCMPT[((size_t)(bgi * 64 + d)) * 512 + i] = ok ? (bf16_t)f2bf(av) : (bf16_t)0;
    }
    __syncthreads();
}

__device__ __forceinline__ float red16(float v) { v += __shfl_xor(v, 1); v += __shfl_xor(v, 2); v += __shfl_xor(v, 4); v += __shfl_xor(v, 8); return v; }
__device__ __forceinline__ int clampd(int d) { return d < 0 ? 0 : (d > 1024 ? 1024 : d); }

__device__ __forceinline__ float ex2(float x) { return __builtin_amdgcn_exp2f(x); }
struct KFrag { bf16x8 k[4][2]; };
struct VFrag { bf16x8 v[2][4]; };
__device__ __forceinline__ void load_k(KFrag& f, const char* kb, unsigned koffB) {
#pragma unroll
    for (int cc = 0; cc < 4; ++cc) { f.k[cc][0] = *(const bf16x8*)(kb + cc * 2048 + koffB); f.k[cc][1] = *(const bf16x8*)(kb + cc * 2048 + 64 + koffB); }
}
__device__ __forceinline__ void load_v(VFrag& f, const char* vb, unsigned voffB, int vstride) {
#pragma unroll
    for (int ks = 0; ks < 2; ++ks)
#pragma unroll
        for (int nt = 0; nt < 4; ++nt) f.v[ks][nt] = *(const bf16x8*)(vb + (size_t)nt * 32 * vstride + ks * 64 + voffB);
}
__device__ __forceinline__ void pv_step(const VFrag& f, f32x4 (&o)[4], const LAS bf16_t* Pb, int r16, int q4) {
    CBAR();
#pragma unroll
    for (int ks = 0; ks < 2; ++ks) { const bf16x8 aP = *(const LAS bf16x8*)(Pb + r16 * 72 + ks * 32 + q4 * 8);
#pragma unroll
        for (int nt = 0; nt < 4; ++nt) o[nt] = MFMA16(aP, f.v[ks][nt], o[nt]); }
    CBAR();
}
__device__ __forceinline__ void qk_scores(const KFrag& f, const LAS bf16_t* qf, f32x4 (&sc)[4]) {
    const f32x4 z4 = {0.f, 0.f, 0.f, 0.f};
    const bf16x8 aq0 = *(const LAS bf16x8*)qf, aq1 = *(const LAS bf16x8*)(qf + 512);
#pragma unroll
    for (int cc = 0; cc < 4; ++cc) { sc[cc] = MFMA16(aq0, f.k[cc][0], z4); sc[cc] = MFMA16(aq1, f.k[cc][1], sc[cc]); }
}
template <int TT> __device__ __forceinline__ void sel_sm(const f32x4 (&sc)[4], int j, int tok, const LAS float* bt, LAS bf16_t* Pb, float& lsum, int r16, int q4) {
#pragma unroll
    for (int cc = 0; cc < 4; ++cc) {
        const int dist = tok - (64 * j + cc * 16 + r16);
        const float p = dist >= 0 ? ex2(sc[cc][TT] + bt[clampd(dist)]) : 0.f; lsum += p;
        Pb[(4 * q4 + TT) * 72 + cc * 16 + r16] = tobf(p);
    }
}
__device__ __forceinline__ void win_sm(const f32x4 (&sc)[4], int gr, int t0, const LAS float* bt, LAS bf16_t* Pb, float (&lw)[4], int r16, int q4) {
#pragma unroll
    for (int cc = 0; cc < 4; ++cc) {
        const int pos = gr * 64 + cc * 16 + r16;
#pragma unroll
        for (int i = 0; i < 4; ++i) { const int dist = t0 + i - pos; const float p = ((unsigned)dist < 512u) ? ex2(sc[cc][i] + bt[clampd(dist)]) : 0.f; lw[i] += p; Pb[(4 * q4 + i) * 72 + cc * 16 + r16] = tobf(p); }
    }
}
__device__ __forceinline__ void cmp_sm1(const f32x4 (&sc)[4], int gr, int t0, const LAS float* bt, float (&ls)[4], int r16) {
#pragma unroll
    for (int cc = 0; cc < 4; ++cc) {
        const int cend = (gr * 64 + cc * 16 + r16) * 16 + 31;
#pragma unroll
        for (int i = 0; i < 4; ++i) { const int dist = t0 + i - cend; ls[i] += dist >= 0 ? ex2(sc[cc][i] + bt[clampd(dist)]) : 0.f; }
    }
}
__device__ __forceinline__ void cmp_sm2(const f32x4 (&sc)[4], int gr, int t0, const LAS float* bt, const float (&inv)[4], LAS bf16_t* Pb, LAS float* psum, int r16, int q4) {
#pragma unroll
    for (int cc = 0; cc < 4; ++cc) {
        const int kk = gr * 64 + cc * 16 + r16, cend = kk * 16 + 31;
#pragma unroll
        for (int i = 0; i < 4; ++i) { const int dist = t0 + i - cend; float p = dist >= 0 ? ex2(sc[cc][i] + bt[clampd(dist)]) * inv[i] : 0.f;
            Pb[(4 * q4 + i) * 72 + cc * 16 + r16] = tobf(p); p += __shfl_xor(p, 16); p += __shfl_xor(p, 32); if (q4 == 0) psum[i * 512 + kk] = p; }
    }
}

__device__ __forceinline__ void nsa_quad_pre(int bg, int quad, const bf16_t* Q, const bf16_t* KV, const bf16_t* KCMP, const bf16_t* VCMPT, const float* GN, bf16_t* ONSA,
                                             const LAS float* btab, LAS bf16_t* Pb, LAS float* psum, LAS int* selq, LAS bf16_t* qfw, int lane) {
    const int r16 = lane & 15, q4 = lane >> 4, b = bg >> 2, g = bg & 3, t0 = quad * 4;
    const unsigned koff = (unsigned)(r16 * 64 + q4 * 8) * 2u, voffS = (unsigned)(r16 * SEQ + q4 * 8) * 2u, voffC = (unsigned)(r16 * 512 + q4 * 8) * 2u;
    const char* KWb = (const char*)(KV + 4 * (size_t)MTOK * 256 + (size_t)bg * SEQ * 64); const char* VWb = (const char*)(KV + 5 * (size_t)MTOK * 256 + (size_t)bg * 64 * SEQ);
    const char* KCb = (const char*)(KCMP + (size_t)bg * 512 * 64); const char* VCb = (const char*)(VCMPT + (size_t)bg * 64 * 512);
#define KP_C(i) KCb + (i) * 8192, koff
#define VP_C(i) VCb + (i) * 128, voffC, 512
#define KP_W(i) KWb + (i) * 8192, koff
#define VP_W(i) VWb + (i) * 128, voffS, SEQ
    const size_t qoff = (size_t)(b * SEQ + t0 + (r16 & 3)) * 1024 + (g * 4 + (r16 >> 2)) * 64 + q4 * 8;
    { const bf16x8 a0 = *(const bf16x8*)(Q + qoff), a1 = *(const bf16x8*)(Q + qoff + 32); *(LAS bf16x8*)(qfw + lane * 8) = a0; *(LAS bf16x8*)(qfw + 512 + lane * 8) = a1; }
    const LAS bf16_t* qf = qfw + lane * 8;
    const LAS float* bt = btab + q4 * 1028;
    const f32x4 z4 = {0.f, 0.f, 0.f, 0.f};
    KFrag KF; VFrag VF; f32x4 sc[4];
    const int w_lo = (t0 - 511 > 0 ? t0 - 511 : 0) >> 6, w_hi = t0 >> 6;
    f32x4 oc[4] = {z4, z4, z4, z4};
    const int tl = t0 + 3, nvmax = tl >= 31 ? ((tl - 31) >> 4) + 1 : 0, ngr = (nvmax + 63) >> 6;
    if (ngr > 0) {
        float ls[4] = {0.f, 0.f, 0.f, 0.f};
        load_k(KF, KP_C(0));
        for (int gr = 0; gr < ngr; ++gr) {
            qk_scores(KF, qf, sc);
            load_k(KF, KP_C(gr + 1 < ngr ? gr + 1 : 0));
            cmp_sm1(sc, gr, t0, bt, ls, r16);
        }
        load_v(VF, VP_C(0));
        float inv[4];
#pragma unroll
        for (int i = 0; i < 4; ++i) { const float l = red16(ls[i]); inv[i] = l > 0.f ? 1.f / l : 0.f; }
        for (int gr = 0; gr < ngr; ++gr) {
            const bool more = gr + 1 < ngr;
            qk_scores(KF, qf, sc);
            if (more) load_k(KF, KP_C(gr + 1));
            cmp_sm2(sc, gr, t0, bt, inv, Pb, psum, r16, q4);
            pv_step(VF, oc, Pb, r16, q4);
            if (more) load_v(VF, VP_C(gr + 1));
        }
    }
    CBAR();
#pragma unroll
    for (int tt = 0; tt < 4; ++tt) {
        const int tok = t0 + tt, cur = tok >> 6;
        if (cur < 16) { if (lane < 16) selq[tt * 16 + lane] = lane; }
        else {
            unsigned k0 = 0u, k1 = 0u;
            { const int j = lane; if (j >= 1 && j <= cur - 2) { const LAS float* ps = psum + tt * 512 + 4 * j - 1; const float v = ps[0] + ps[1] + ps[2] + ps[3] + ps[4]; k0 = (__builtin_bit_cast(unsigned, v) & ~127u) | (unsigned)(127 - j); } }
            { const int j = lane + 64; if (j <= cur - 2) { const LAS float* ps = psum + tt * 512 + 4 * j - 1; const float v = ps[0] + ps[1] + ps[2] + ps[3] + ps[4]; k1 = (__builtin_bit_cast(unsigned, v) & ~127u) | (unsigned)(127 - j); } }
            for (int it = 0; it < 13; ++it) {
                unsigned m = k0 > k1 ? k0 : k1;
#pragma unroll
                for (int off = 32; off >= 1; off >>= 1) { const unsigned o = (unsigned)__shfl_xor((int)m, off); m = o > m ? o : m; }
                if (k0 == m) k0 = 0u; if (k1 == m) k1 = 0u;
                if (lane == 0) selq[tt * 16 + it] = 127 - (int)(m & 127u);
            }
            if (lane == 0) { selq[tt * 16 + 13] = 0; selq[tt * 16 + 14] = cur - 1; selq[tt * 16 + 15] = cur; }
        }
    }
    CBAR();
#pragma unroll
    for (int tt = 0; tt < 4; ++tt) { const float gc = GN[(size_t)(b * SEQ + t0 + tt) * 48 + (g * 4 + q4) * 3];
        bf16_t* op = ONSA + (size_t)(b * SEQ + t0 + tt) * 1024 + (g * 4 + q4) * 64 + r16;
#pragma unroll
        for (int nt = 0; nt < 4; ++nt) op[nt * 16] = tobf(gc * oc[nt][tt]); }
#undef KP_C
#undef VP_C
#undef KP_W
#undef VP_W
}

template <int MODE>
__device__ __forceinline__ void nsa_block_loop(int bg, int qb, const bf16_t* Q, const bf16_t* KV, const float* GN, bf16_t* ONSA, const LAS float* btab, LAS bf16_t* Pb,
                                               const LAS int* selall, LAS unsigned* masks, LAS bf16_t* stage, int tid, int lane, int wave) {
    const int r16 = lane & 15, q4 = lane >> 4, b = bg >> 2, g = bg & 3;
    const bf16_t* Kt = KV + (MODE ? 4 : 2) * (size_t)MTOK * 256 + (size_t)bg * SEQ * 64; const bf16_t* Vt = KV + (MODE ? 5 : 3) * (size_t)MTOK * 256 + (size_t)bg * 64 * SEQ;
    const LAS float* bt = btab + q4 * 1028;
    const float bfar = bt[1024];
    const f32x4 z4 = {0.f, 0.f, 0.f, 0.f};
    const int j0 = MODE ? (qb - 8 > 0 ? qb - 8 : 0) : 0;
    if (MODE == 0 && tid < 256) { const int tok = tid >> 2, word = tid & 3; unsigned m = 0u;
        if (qb < 16) m = word == 0 ? ((2u << qb) - 1u) : 0u;
        else {
#pragma unroll
            for (int n = 0; n < 16; ++n) { const int j = selall[tok * 16 + n]; m |= ((j >> 5) == word) ? (1u << (j & 31)) : 0u; } }
        masks[tid] = m; }
    bf16x8 aq[2][2];
#pragma unroll
    for (int tile = 0; tile < 2; ++tile) { const int t0 = qb * 64 + wave * 8 + tile * 4;
        const size_t qoff = (size_t)(b * SEQ + t0 + (r16 & 3)) * 1024 + (g * 4 + (r16 >> 2)) * 64 + q4 * 8;
        aq[tile][0] = *(const bf16x8*)(Q + qoff); aq[tile][1] = *(const bf16x8*)(Q + qoff + 32); }
    f32x4 os[2][4]; float ls[2][4];
#pragma unroll
    for (int tile = 0; tile < 2; ++tile)
#pragma unroll
        for (int i = 0; i < 4; ++i) { os[tile][i] = z4; ls[tile][i] = 0.f; }
    const int srow = tid >> 3, sch = tid & 7, soff = srow * 72 + sch * 8;
    const unsigned kgo = (unsigned)(srow * 64 + sch * 8) * 2u, vgo = (unsigned)(srow * SEQ + sch * 8) * 2u;
#define NSA_LD1(jj) do { kr = *(const bf16x8*)((const char*)Kt + (size_t)(jj) * 8192 + kgo); vr = *(const bf16x8*)((const char*)Vt + (jj) * 128 + vgo); } while (0)
#define NSA_ST1(st_, half_) do { LAS bf16_t* nx_ = stage + (st_) * 18432 + (half_) * 9216 + soff; *(LAS bf16x8*)nx_ = kr; *(LAS bf16x8*)(nx_ + 4608) = vr; } while (0)
    bf16x8 kr, vr;
    NSA_LD1(j0); NSA_ST1(0, 0);
    if (j0 + 1 <= qb) { NSA_LD1(j0 + 1); NSA_ST1(0, 1); }
    __syncthreads();
    for (int jA = j0, pp = 0; jA <= qb; jA += 2, pp ^= 1) {
      for (int sub = 0; sub < 2; ++sub) {
        const int j = jA + sub; if (j > qb) break;
        const bool pre = j + 2 <= qb;
        if (pre) NSA_LD1(j + 2);
        const LAS bf16_t* Ks = stage + pp * 18432 + sub * 9216; const LAS bf16_t* Vs = Ks + 4608;
        const bool far = MODE == 0 && (qb - j >= 17);
#pragma unroll
        for (int tile = 0; tile < 2; ++tile) {
            const int tl0 = wave * 8 + tile * 4, t0 = qb * 64 + tl0;
            unsigned mb[4] = {1u, 1u, 1u, 1u};
            if (MODE == 0) {
#pragma unroll
                for (int i = 0; i < 4; ++i) mb[i] = (masks[(tl0 + i) * 4 + (j >> 5)] >> (j & 31)) & 1u; }
            if (MODE == 1 || __builtin_amdgcn_readfirstlane((int)(mb[0] | mb[1] | mb[2] | mb[3]))) {
                f32x4 sc[4];
#pragma unroll
                for (int cc = 0; cc < 4; ++cc) { const LAS bf16_t* kp = Ks + (cc * 16 + r16) * 72 + q4 * 8;
                    sc[cc] = MFMA16(aq[tile][0], *(const LAS bf16x8*)kp, z4); sc[cc] = MFMA16(aq[tile][1], *(const LAS bf16x8*)(kp + 32), sc[cc]); }
                if (far) {
#pragma unroll
                    for (int cc = 0; cc < 4; ++cc)
#pragma unroll
                        for (int i = 0; i < 4; ++i) { const float p = mb[i] ? ex2(sc[cc][i] + bfar) : 0.f; ls[tile][i] += p; Pb[(4 * q4 + i) * 72 + cc * 16 + r16] = tobf(p); }
                } else {
#pragma unroll
                    for (int cc = 0; cc < 4; ++cc) { const int pos = j * 64 + cc * 16 + r16;
#pragma unroll
                        for (int i = 0; i < 4; ++i) { const int dist = t0 + i - pos; const bool ok = MODE ? ((unsigned)dist < 512u) : (dist >= 0 && mb[i]);
                            const float p = ok ? ex2(sc[cc][i] + bt[clampd(dist)]) : 0.f; ls[tile][i] += p; Pb[(4 * q4 + i) * 72 + cc * 16 + r16] = tobf(p); } }
                }
                CBAR();
#pragma unroll
                for (int ks = 0; ks < 2; ++ks) { const bf16x8 aP = *(const LAS bf16x8*)(Pb + r16 * 72 + ks * 32 + q4 * 8);
#pragma unroll
                    for (int nt = 0; nt < 4; ++nt) os[tile][nt] = MFMA16(aP, *(const LAS bf16x8*)(Vs + (nt * 16 + r16) * 72 + ks * 32 + q4 * 8), os[tile][nt]); }
                CBAR();
            }
        }
        if (pre) NSA_ST1(pp ^ 1, sub);
      }
        __syncthreads();
    }
#undef NSA_LD1
#undef NSA_ST1
#pragma unroll
    for (int tile = 0; tile < 2; ++tile) { const int t0 = qb * 64 + wave * 8 + tile * 4;
#pragma unroll
        for (int tt = 0; tt < 4; ++tt) { const float gs = GN[(size_t)(b * SEQ + t0 + tt) * 48 + (g * 4 + q4) * 3 + (MODE ? 2 : 1)] / red16(ls[tile][tt]);
            bf16_t* op = ONSA + (size_t)(b * SEQ + t0 + tt) * 1024 + (g * 4 + q4) * 64 + r16;
#pragma unroll
            for (int nt = 0; nt < 4; ++nt) op[nt * 16] = tobf(bflo((unsigned)op[nt * 16]) + gs * os[tile][nt][tt]); } }
}

__device__ __forceinline__ int t5_bucket(int d) {
    if (d < 16) return d;
    if (d >= 1024) return 31;
    int k = 0;
    k += d >= 21; k += d >= 27; k += d >= 35; k += d >= 46; k += d >= 59; k += d >= 77; k += d >= 99; k += d >= 128;
    k += d >= 166; k += d >= 216; k += d >= 280; k += d >= 363; k += d >= 470; k += d >= 609; k += d >= 790;
    return 16 + k;
}
__device__ __forceinline__ void nsa_phase(LAS unsigned char* lds, const bf16_t* Q, const bf16_t* KV, const bf16_t* KCMP, const bf16_t* VCMPT, const float* GN, const float* rel_bias, bf16_t* ONSA,
                                          int tid, int lane, int wave) {
    LAS float* btab = (LAS float*)lds;
    LAS bf16_t* Pb = (LAS bf16_t*)(lds + 16448 + wave * 2304);
    LAS bf16_t* qfw = (LAS bf16_t*)(lds + 34880 + wave * 2048);
    LAS int* selall = (LAS int*)(lds + 51264);
    LAS unsigned* masks = (LAS unsigned*)(lds + 55360);
    LAS float* psum = (LAS float*)(lds + 56384 + wave * 8192);
    LAS bf16_t* stage = (LAS bf16_t*)(lds + 56384);
    for (int i = lane; i < 576; i += 64) ((LAS unsigned*)Pb)[i] = 0u;
    for (int vb = blockIdx.x; vb < 256; vb += gridDim.x) {
        const int xcd = vb & 7, idx = vb >> 3;
        for (int pass = 0; pass < 2; ++pass) {
            const int bg = xcd + 8 * pass, g = bg & 3;
            __syncthreads();
            for (int i2 = tid; i2 < 4 * 1025; i2 += NTHREADS) { const int hh = i2 / 1025, dd = i2 - hh * 1025; btab[hh * 1028 + dd] = 1.44269504089f * rel_bias[t5_bucket(dd) * 16 + g * 4 + hh]; }
            __syncthreads();
            for (int kk = 0; kk < 4; ++kk) {
                const int qb = (kk & 1) ? (32 * kk + 31 - idx) : (32 * kk + idx);
                nsa_quad_pre(bg, qb * 16 + wave * 2, Q, KV, KCMP, VCMPT, GN, ONSA, btab, Pb, psum, selall + (wave * 2) * 64, qfw, lane);
                nsa_quad_pre(bg, qb * 16 + wave * 2 + 1, Q, KV, KCMP, VCMPT, GN, ONSA, btab, Pb, psum, selall + (wave * 2 + 1) * 64, qfw, lane);
                __syncthreads();
                nsa_block_loop<0>(bg, qb, Q, KV, GN, ONSA, btab, Pb, selall, masks, stage, tid, lane, wave);
                nsa_block_loop<1>(bg, qb, Q, KV, GN, ONSA, btab, Pb, selall, masks, stage, tid, lane, wave);
            }
        }
    }
    __syncthreads();
}

#define XB_TMO      128
#define XB_XCNT(j)  (256  + 64 * (j))
#define XB_XSUB(j)  (1280 + 64 * (j))
#define XB_XGEN(j)  (2304 + 64 * (j))
#define XB_TOP      3328
#define XB_TOPGEN   3392
#define XCD_BAR_WORDS 3456
#define XB_SPIN_CAP (1u << 18)

__device__ __forceinline__ unsigned xb_ld(unsigned* p)              { return __hip_atomic_load(p, __ATOMIC_RELAXED, __HIP_MEMORY_SCOPE_AGENT); }
__device__ __forceinline__ unsigned xb_add(unsigned* p, unsigned v) { return __hip_atomic_fetch_add(p, v, __ATOMIC_RELAXED, __HIP_MEMORY_SCOPE_AGENT); }
__device__ __forceinline__ unsigned xb_xcc_id() { return (unsigned)__builtin_amdgcn_s_getreg((3 << 11) | 20) & 0xFu; }
#define XB_SPIN(cond, bar) do { unsigned _sp = 0; while (cond) { __builtin_amdgcn_s_sleep(1); \
    if ((++_sp & 255u) == 0u) { if (xb_ld(&(bar)[XB_TMO])) break; if (_sp > XB_SPIN_CAP) { atomicAdd(&(bar)[XB_TMO], 1u); break; } } } } while (0)

struct XcdBarrier {
    unsigned* bar; unsigned x;
    volatile LAS unsigned* st;
};

__device__ __forceinline__ XcdBarrier xcd_barrier_post(unsigned* bar, volatile LAS unsigned* st) {
    XcdBarrier b; b.bar = bar; b.x = xb_xcc_id(); b.st = st;
    if (threadIdx.x == 0) (void)xb_add(&bar[XB_XCNT(b.x)], 1u);
    return b;
}
__device__ __forceinline__ void xcd_barrier_complete(unsigned* bar, unsigned x, unsigned& nloc, unsigned& nx) {
    const unsigned G = gridDim.x * gridDim.y * gridDim.z;
    unsigned sum, cnt, mine, sp = 0u;
    for (;;) {
        sum = 0u; cnt = 0u; mine = 0u;
#pragma unroll
        for (unsigned j = 0; j < 16; ++j) { const unsigned c = xb_ld(&bar[XB_XCNT(j)]); sum += c; cnt += (c > 0u) ? 1u : 0u; mine = (j == x) ? c : mine; }
        if (sum == G) break;
        __builtin_amdgcn_s_sleep(1);
        if ((++sp & 255u) == 0u) { if (xb_ld(&bar[XB_TMO])) break; if (sp > XB_SPIN_CAP) { atomicAdd(&bar[XB_TMO], 1u); break; } }
    }
    nloc = mine > 0u ? mine : 1u; nx = cnt > 0u ? cnt : 1u;
}

__device__ __forceinline__ void xcd_barrier(const XcdBarrier& b) {
    asm volatile("s_waitcnt vmcnt(0)" ::: "memory");
    __syncthreads();
    if (threadIdx.x == 0) {
        unsigned* bar = b.bar;
        __builtin_amdgcn_s_waitcnt(0);
        unsigned nloc = b.st[0], nx = b.st[1];
        if (nloc == 0u) { xcd_barrier_complete(bar, b.x, nloc, nx); b.st[0] = nloc; b.st[1] = nx; }
        const unsigned old = xb_add(&bar[XB_XSUB(b.x)], 1u);
        const unsigned gen = old / nloc;
        if (old + 1u == (gen + 1u) * nloc) {
            __builtin_amdgcn_fence(__ATOMIC_RELEASE, "agent");
            asm volatile("s_waitcnt vmcnt(0)" ::: "memory");
            const unsigned og = xb_add(&bar[XB_TOP], 1u);
            const unsigned tg = og / nx;
            if (og + 1u == (tg + 1u) * nx) xb_add(&bar[XB_TOPGEN], 1u);
            else XB_SPIN(xb_ld(&bar[XB_TOPGEN]) == tg, bar);
            __builtin_amdgcn_fence(__ATOMIC_ACQUIRE, "agent");
            xb_add(&bar[XB_XGEN(b.x)], 1u);
            asm volatile("s_waitcnt vmcnt(0)" ::: "memory");
        } else {
            XB_SPIN(xb_ld(&bar[XB_XGEN(b.x)]) == gen, bar);
            __builtin_amdgcn_fence(__ATOMIC_ACQUIRE, "agent");
            asm volatile("s_waitcnt vmcnt(0)" ::: "memory");
        }
    }
    __syncthreads();
}


__global__ void __launch_bounds__(NTHREADS, 2) fwd_kernel(Params P) {
    extern __shared__ __attribute__((aligned(16))) unsigned char lds_raw[];
    LAS unsigned char* lds = (LAS unsigned char*)lds_raw;
    cg::grid_group grid = cg::this_grid();
    int tid = threadIdx.x, lane = tid & 63, wave = __builtin_amdgcn_readfirstlane(tid >> 6);
    const int G = gridDim.x, NGW = G * 8; int gw = blockIdx.x * 8 + wave;
#define REIDS() do { tid = threadIdx.x; asm volatile("" : "+v"(tid)); lane = tid & 63; wave = __builtin_amdgcn_readfirstlane(tid >> 6); gw = blockIdx.x * 8 + wave; } while (0)
    ((LAS int*)(lds + 145408))[tid] = tid; if (tid < 2) ((LAS unsigned*)(lds + 131072))[tid] = 0u; __syncthreads();
    const XcdBarrier xbar = xcd_barrier_post((unsigned*)(P.ws + WS_BAR), (volatile LAS unsigned*)(lds + 131072));
    unsigned char* ws = P.ws;
    bf16_t* W1GU = (bf16_t*)(ws + WS_W1GU); bf16_t* W1D = (bf16_t*)(ws + WS_W1D); bf16_t* W2GU = (bf16_t*)(ws + WS_W2GU); bf16_t* W2D = (bf16_t*)(ws + WS_W2D);
    bf16_t* WIN = (bf16_t*)(ws + WS_WIN); bf16_t* WGLU = (bf16_t*)(ws + WS_WGLU); bf16_t* WO = (bf16_t*)(ws + WS_WO); bf16_t* WOUT = (bf16_t*)(ws + WS_WOUT);
    bf16_t* CKW1 = (bf16_t*)(ws + WS_CKW1); bf16_t* CVW1 = (bf16_t*)(ws + WS_CVW1);
    bf16_t* XN = (bf16_t*)(ws + WS_XN); bf16_t* ACT = (bf16_t*)(ws + WS_ACT); bf16_t* FB = (bf16_t*)(ws + WS_F); bf16_t* KV = (bf16_t*)(ws + WS_KV);
    bf16_t* YSSM = XN; bf16_t* ONSA = XN + (size_t)MTOK * 1024;
    bf16_t* GA = ACT; bf16_t* GB = ACT + (size_t)MTOK * 2048; bf16_t* USSM = ACT + (size_t)MTOK * 4096; bf16_t* MIXED = ACT;
    bf16_t* QB = FB; bf16_t* MERGED = FB;
    bf16_t* H1K = (bf16_t*)(ws + WS_H1K); bf16_t* H1V = (bf16_t*)(ws + WS_H1V); bf16_t* KCMP = (bf16_t*)(ws + WS_KCMP); bf16_t* VCMPT = (bf16_t*)(ws + WS_VCMPT);
    float* GN = (float*)(ws + WS_GN); float* S5A = (float*)(ws + WS_S5A); float* S5B = (float*)(ws + WS_S5B); float* CB = (float*)(ws + WS_CB);
    const float* x = P.in[0]; float* out = P.out;

    {
        LAS float* scr = (LAS float*)(lds + wave * 16384);
        constexpr int I_FF = 5632, I_IN = 7936, I_GL = 1024, I_OUT = 2048, I_C = 256;
        constexpr int NITEMS = 6 * I_FF + I_IN + 3 * I_GL + I_OUT + 2 * I_C;
        for (int it = gw; it < NITEMS; it += NGW) {
            int r = it;
            if (r < I_FF) { tr_job(P.in[2], DFF, DM, 176, W1GU, r, 1, scr, lane); continue; } r -= I_FF;
            if (r < I_FF) { tr_job(P.in[3], DFF, DM, 176, W1GU, r, 2, scr, lane); continue; } r -= I_FF;
            if (r < I_FF) { tr_job(P.in[4], DM, DFF, 64, W1D, r, 0, scr, lane); continue; } r -= I_FF;
            if (r < I_FF) { tr_job(P.in[27], DFF, DM, 176, W2GU, r, 1, scr, lane); continue; } r -= I_FF;
            if (r < I_FF) { tr_job(P.in[28], DFF, DM, 176, W2GU, r, 2, scr, lane); continue; } r -= I_FF;
            if (r < I_FF) { tr_job(P.in[29], DM, DFF, 64, W2D, r, 0, scr, lane); continue; } r -= I_FF;
            if (r < I_IN) { tr_job(P.in[7], 7728, DM, 248, WIN, r, 3, scr, lane); continue; } r -= I_IN;
            if (r < I_GL) { tr_job(P.in[16], 2048, 1024, 64, WGLU, r, 1, scr, lane); continue; } r -= I_GL;
            if (r < I_GL) { tr_job(P.in[17], 2048, 1024, 64, WGLU, r, 2, scr, lane); continue; } r -= I_GL;
            if (r < I_GL) { tr_job(P.in[23], 2048, 1024, 64, WO, r, 0, scr, lane); continue; } r -= I_GL;
            if (r < I_OUT) { tr_job(P.in[24], 2048, 2048, 64, WOUT, r, 0, scr, lane); continue; } r -= I_OUT;
            if (r < I_C) { tr_job(P.in[19], 256, 2048, 8, CKW1, r, 0, scr, lane); continue; } r -= I_C;
            tr_job(P.in[21], 256, 2048, 8, CVW1, r, 0, scr, lane);
        }
        for (int m = gw; m < MTOK; m += NGW) norm_row(x + (size_t)m * DM, P.in[1], XN + (size_t)m * DM, lane);
        const int gid = blockIdx.x * NTHREADS + tid;
        if (gid < 4096) {
            const int g = gid >> 6;
            const float dt = expf(P.in[10][g]); const float lre = fminf(P.in[8][gid], -1e-4f), lim = P.in[9][gid];
            const float mag = expf(lre * dt);
            double th = (double)lim * (double)dt; th -= 6.283185307179586476925 * rint(th * 0.15915494309189533577); const double t2 = th * th;
            double sn = 1.0, cs = 1.0;
            { double term = 1.0; double s = 0.0, c = 0.0; for (int k = 0; k < 14; ++k) { c += term; term *= th / (double)(2 * k + 1); s += term; term *= -th / (double)(2 * k + 2); } sn = s; cs = c; (void)t2; }
            const float are = mag * (float)cs, aim = mag * (float)sn;
            const float den = lre * lre + lim * lim, nre = are - 1.f, nim = aim;
            const float cre = (nre * lre + nim * lim) / den, cim = (nim * lre - nre * lim) / den;
            S5A[gid * 2] = are; S5A[gid * 2 + 1] = aim;
            for (int c = 0; c < 16; ++c) { const float br = P.in[11][gid * 16 + c], bi = P.in[12][gid * 16 + c]; S5B[(size_t)gid * 32 + c] = cre * br - cim * bi; S5B[(size_t)gid * 32 + 16 + c] = cre * bi + cim * br; }
        }
    }
    grid.sync(); REIDS();
    { pg8::Gemm gm{XN, W1GU, MTOK, 2 * DFF, DM, DM}; pg8::StaticOrder S; S.init(MTOK, 2 * DFF, G, (int)blockIdx.x); EpiSwiGLU E{ACT, DFF}; pg8::gemm_phase<true>(lds, gm, S, E); }
    xcd_barrier(xbar); REIDS();
    { pg8::Gemm gm{ACT, W1D, MTOK, DM, DFF, DFF}; pg8::StaticOrder S; S.init(MTOK, DM, G, (int)blockIdx.x); EpiStore E{FB, DM}; pg8::gemm_phase<true>(lds, gm, S, E); }
    xcd_barrier(xbar); REIDS();
    for (int m = gw; m < MTOK; m += NGW) rowwise_row(FB + (size_t)m * DM, x + (size_t)m * DM, 0.5f, P.in[5], out + (size_t)m * DM, P.in[6], XN + (size_t)m * DM, lane);
    if (gw < 512) { const int n = gw & 255; const bf16_t* wrow = (gw >> 8 ? CVW1 : CKW1) + (size_t)n * 2048; float s = 0.f;
#pragma unroll
        for (int j = 0; j < 4; ++j) { const int c = 512 * j + 8 * lane; f32x4 w0, w1; unpack8(*(const u32x4*)(wrow + c), w0, w1); const f32x4 p0 = *(const f32x4*)(P.in[18] + c), p1 = *(const f32x4*)(P.in[18] + c + 4);
#pragma unroll
            for (int i = 0; i < 4; ++i) s += w0[i] * p0[i] + w1[i] * p1[i]; }
        s = wave_sum(s); if (lane == 0) CB[gw] = s; }
#if PROGRAM_END > 3
    xcd_barrier(xbar); REIDS();
    { pg8::Gemm gm{XN, WIN, MTOK, NIN, DM, DM}; pg8::StaticOrder S; S.init(MTOK, NIN, G, (int)blockIdx.x); EpiIn E{USSM, QB, KV, GA, GB, GN}; pg8::gemm_phase<false>(lds, gm, S, E); }
    xcd_barrier(xbar); REIDS();
    { pg8::Gemm gm{KV, CKW1, 8192, 256, 2048, 1024}; pg8::StaticOrder S; S.init(8192, 256, G, (int)blockIdx.x); EpiCmp E{H1K, CB}; pg8::gemm_phase<false>(lds, gm, S, E); }
    { pg8::Gemm gm{KV + (size_t)MTOK * 256, CVW1, 8192, 256, 2048, 1024}; pg8::StaticOrder S; S.init(8192, 256, G, (int)((blockIdx.x + G - 32) % G)); EpiCmp E{H1V, CB + 256}; pg8::gemm_phase<false>(lds, gm, S, E); }
    s5_phase(lds, USSM, S5A, S5B, P.in[13], P.in[14], P.in[15], YSSM, tid, lane, wave);
    xcd_barrier(xbar); REIDS();
    cmp2_phase(lds, H1K, H1V, P.in[20], P.in[22], KCMP, VCMPT, tid);
    xcd_barrier(xbar); REIDS();
    nsa_phase(lds, QB, KV, KCMP, VCMPT, GN, P.in[31], ONSA, tid, lane, wave);
    xcd_barrier(xbar); REIDS();
    { pg8::Gemm gm{YSSM, WGLU, MTOK, 4096, 1024, 1024}; pg8::StaticOrder S; S.init(MTOK, 4096, G, (int)blockIdx.x); EpiGLU E{MERGED, GA}; pg8::gemm_phase<true>(lds, gm, S, E); }
    xcd_barrier(xbar); REIDS();
    { pg8::Gemm gm{ONSA, WO, MTOK, 2048, 1024, 1024}; pg8::StaticOrder S; S.init(MTOK, 2048, G, (int)blockIdx.x); EpiWo E{MERGED, GB}; pg8::gemm_phase<true>(lds, gm, S, E); }
    xcd_barrier(xbar); REIDS();
    { pg8::Gemm gm{MERGED, WOUT, MTOK, 2048, 2048, 2048}; pg8::StaticOrder S; S.init(MTOK, 2048, G, (int)blockIdx.x); EpiStore E{MIXED, DM}; pg8::gemm_phase<true>(lds, gm, S, E); }
    xcd_barrier(xbar); REIDS();
    for (int m = gw; m < MTOK; m += NGW) rowwise_row(MIXED + (size_t)m * DM, out + (size_t)m * DM, 1.0f, P.in[25], out + (size_t)m * DM, P.in[26], XN + (size_t)m * DM, lane);
#endif
#if PROGRAM_END > 11
    xcd_barrier(xbar); REIDS();
    { pg8::Gemm gm{XN, W2GU, MTOK, 2 * DFF, DM, DM}; pg8::StaticOrder S; S.init(MTOK, 2 * DFF, G, (int)blockIdx.x); EpiSwiGLU E{ACT, DFF}; pg8::gemm_phase<true>(lds, gm, S, E); }
    xcd_barrier(xbar); REIDS();
    { pg8::Gemm gm{ACT, W2D, MTOK, DM, DFF, DFF}; pg8::StaticOrder S; S.init(MTOK, DM, G, (int)blockIdx.x); EpiStore E{FB, DM}; pg8::gemm_phase<true>(lds, gm, S, E); }
    xcd_barrier(xbar); REIDS();
    for (int m = gw; m < MTOK; m += NGW) rowwise_row(FB + (size_t)m * DM, out + (size_t)m * DM, 0.5f, P.in[30], out + (size_t)m * DM, nullptr, nullptr, lane);
#endif
}

extern "C" void kernel_launch(void* const* d_in, const int* in_sizes, int n_in, void* d_out, int out_size, void* d_ws, size_t ws_size, hipStream_t stream) {
    static int grid_blocks = 0;
    if (!grid_blocks) {
        int dev = 0, cus = 0, per_cu = 0;
        hipGetDevice(&dev);
        hipDeviceGetAttribute(&cus, hipDeviceAttributeMultiprocessorCount, dev);
        hipFuncSetAttribute((const void*)fwd_kernel, hipFuncAttributeMaxDynamicSharedMemorySize, LDS_BYTES);
        hipOccupancyMaxActiveBlocksPerMultiprocessor(&per_cu, (const void*)fwd_kernel, NTHREADS, LDS_BYTES);
        if (per_cu < 1) per_cu = 1;
        grid_blocks = cus * per_cu; if (grid_blocks > 256) grid_blocks = 256;
        if (ws_size < WS_END || n_in != 32) fprintf(stderr, "kernel_launch: unexpected ws_size %zu (need %zu) or n_in %d\n", ws_size, (size_t)WS_END, n_in);
    }
    hipMemsetAsync((char*)d_ws + WS_BAR, 0, 3456 * 4, stream);
    Params p{};
    for (int i = 0; i < 32; ++i) p.in[i] = (const float*)d_in[i];
    p.out = (float*)d_out; p.ws = (unsigned char*)d_ws;
    void* args[] = {&p};
    hipError_t e = hipLaunchCooperativeKernel((const void*)fwd_kernel, dim3(grid_blocks), dim3(NTHREADS), args, LDS_BYTES, stream);
    if (e != hipSuccess) fprintf(stderr, "cooperative launch failed: %s (grid %d)\n", hipGetErrorString(e), grid_blocks);
}
```

```cpp
#include <hip/hip_runtime.h>
#include <hip/hip_cooperative_groups.h>
#include <cstdio>
#include <cstdint>
namespace cg = cooperative_groups;

#define LAS __attribute__((address_space(3)))
typedef unsigned short bf16_t;
typedef short bf16x8 __attribute__((ext_vector_type(8)));
typedef float f32x4 __attribute__((ext_vector_type(4)));
typedef unsigned u32x4 __attribute__((ext_vector_type(4)));
typedef unsigned u32x2 __attribute__((ext_vector_type(2)));

#ifndef PROGRAM_END
#define PROGRAM_END 99
#endif

constexpr int MTOK = 32768, DM = 2048, DFF = 5632, SEQ = 8192;
constexpr int NIN = 7936;
constexpr int LDS_BYTES = 147456;
constexpr int NTHREADS = 512;
constexpr float EPS = 1e-6f;

constexpr size_t SZ_WGU = (size_t)2 * DFF * DM * 2, SZ_WD = (size_t)DM * DFF * 2;
constexpr size_t WS_W1GU = 0;
constexpr size_t WS_W1D = WS_W1GU + SZ_WGU;
constexpr size_t WS_W2GU = WS_W1D + SZ_WD;
constexpr size_t WS_W2D = WS_W2GU + SZ_WGU;
constexpr size_t WS_WIN = WS_W2D + SZ_WD;
constexpr size_t WS_WGLU = WS_WIN + (size_t)NIN * DM * 2;
constexpr size_t WS_WO = WS_WGLU + (size_t)4096 * 1024 * 2;
constexpr size_t WS_WOUT = WS_WO + (size_t)2048 * 1024 * 2;
constexpr size_t WS_CKW1 = WS_WOUT + (size_t)2048 * 2048 * 2;
constexpr size_t WS_CVW1 = WS_CKW1 + (size_t)256 * 2048 * 2;
constexpr size_t WS_XN = WS_CVW1 + (size_t)256 * 2048 * 2;
constexpr size_t WS_ACT = WS_XN + (size_t)MTOK * DM * 2;
constexpr size_t WS_F = WS_ACT + (size_t)MTOK * DFF * 2;
constexpr size_t WS_KV = WS_F + (size_t)MTOK * DM * 2;
constexpr size_t SZ_KV1 = (size_t)MTOK * 256 * 2;
constexpr size_t WS_H1K = WS_KV + 6 * SZ_KV1 + 65536;
constexpr size_t WS_H1V = WS_H1K + (size_t)8192 * 256 * 2;
constexpr size_t WS_KCMP = WS_H1V + (size_t)8192 * 256 * 2;
constexpr size_t WS_VCMPT = WS_KCMP + (size_t)16 * 512 * 64 * 2;
constexpr size_t WS_GN = WS_VCMPT + (size_t)16 * 512 * 64 * 2;
constexpr size_t WS_S5A = WS_GN + (size_t)MTOK * 48 * 4;
constexpr size_t WS_S5B = WS_S5A + (size_t)64 * 64 * 2 * 4;
constexpr size_t WS_CB = WS_S5B + (size_t)64 * 64 * 32 * 4;
constexpr size_t WS_BAR = WS_CB + 2 * 256 * 4;
constexpr size_t WS_END = WS_BAR + 3456 * 4;

__device__ __forceinline__ unsigned f2bf(float f) { unsigned u = __builtin_bit_cast(unsigned, f); return (u + 0x7fffu + ((u >> 16) & 1u)) >> 16; }
__device__ __forceinline__ unsigned pk2(float lo, float hi) { unsigned r; asm volatile("v_cvt_pk_bf16_f32 %0, %1, %2" : "=v"(r) : "v"(lo), "v"(hi)); return r; }
__device__ __forceinline__ float bflo(unsigned u) { return __builtin_bit_cast(float, u << 16); }
__device__ __forceinline__ float bfhi(unsigned u) { return __builtin_bit_cast(float, u & 0xffff0000u); }
__device__ __forceinline__ float fexp(float x) { return __builtin_amdgcn_exp2f(x * 1.44269504089f); }
__device__ __forceinline__ float sigm(float x) { return __builtin_amdgcn_rcpf(1.f + fexp(-x)); }
__device__ __forceinline__ float silu(float x) { return x * sigm(x); }
__device__ __forceinline__ float gelu_tanh(float x) { return x * sigm(1.5957691216f * (x + 0.044715f * x * x * x)); }
__device__ __forceinline__ float wave_sum(float v) {
#pragma unroll
    for (int o = 1; o < 64; o <<= 1) v += __shfl_xor(v, o);
    return v;
}
#define LDS_WAIT() asm volatile("s_waitcnt lgkmcnt(0)" ::: "memory")
#define CBAR() asm volatile("" ::: "memory")
#define MFMA16(a, b, c) __builtin_amdgcn_mfma_f32_16x16x32_bf16(a, b, c, 0, 0, 0)
__device__ __forceinline__ bf16_t tobf(float x) { return (bf16_t)pk2(x, 0.f); }

namespace pg8 {
constexpr int BM = 256, BK = 64, HALF = 128, HTB = HALF * BK * 2, STAGE_BYTES = 8 * HTB, NXCD = 8, WGM = 8;
__host__ __device__ __forceinline__ int lds_byte(int r, int c) { const int st = (r >> 4) * 2 + (c >> 5), rr = r & 15, cc = c & 31, ob = rr * 64 + cc * 2; return st * 1024 + (ob ^ (((ob >> 9) & 1) << 5)); }
__host__ __device__ __forceinline__ void stage_rc(int b, int& R, int& C) { const int st = b / 1024, sb = b % 1024, swz = sb ^ (((sb >> 9) & 1) << 5); R = (st >> 1) * 16 + swz / 64; C = (st & 1) * 32 + (swz % 64) / 2; }
__host__ __device__ __forceinline__ int perm32(int rho) { const int n = rho >> 4, i = rho & 15; return 8 * (i >> 2) + 4 * n + (i & 3); }

struct Unit { int pm, pn; };
struct Gemm { const bf16_t* A; const bf16_t* Bt; int M, N, K, lda; };

struct StaticOrder {
    int nM, nN, nwg, G, c;
    __device__ void init(int M, int N, int G_, int c_) { nM = M / BM; nN = N / BM; nwg = nM * nN; G = G_; c = c_; }
    __device__ bool next(int i, Unit& u) const {
        const long L = (long)i * G + c; if (L >= nwg) return false;
        int wgid = (int)L; { const int q = nwg / NXCD, r = nwg % NXCD, xcd = wgid % NXCD, off = wgid / NXCD; wgid = (xcd < r ? xcd * (q + 1) : r * (q + 1) + (xcd - r) * q) + off; }
        const int nig = WGM * nN, gid = wgid / nig, fm = gid * WGM, gsz = (nM - fm) < WGM ? (nM - fm) : WGM;
        u.pm = fm + ((wgid % nig) % gsz); u.pn = (wgid % nig) / gsz; return true;
    }
};

template <bool LT, class Epi>
__device__ __forceinline__ void gemm_phase(LAS unsigned char* lds, const Gemm g, const StaticOrder& S, const Epi& E) {
    const int tid = LT ? ((const LAS int*)(lds + 145408))[threadIdx.x] : (int)threadIdx.x;
    const int wid = __builtin_amdgcn_readfirstlane(tid >> 6), lane = tid & 63, wr = wid >> 2, wc = wid & 3, fr = lane & 15, fq = lane >> 4;
    const int K = g.K, nt = K / BK, lda = g.lda;
    unsigned voffA[2], voffB[2];
#pragma unroll
    for (int i = 0; i < 2; ++i) { int R, C; stage_rc(tid * 16 + i * 8192, R, C); const int Rb = Epi::PERM ? ((R & ~31) + perm32(R & 31)) : R;
        voffA[i] = (unsigned)(R * lda + C) * 2u; voffB[i] = (unsigned)(Rb * K + C) * 2u; }
    const size_t kstep = (size_t)(BK * 2);
    const size_t hstepA = (size_t)HALF * lda * 2, hstepB = (size_t)HALF * K * 2;
    const size_t tstepA = 2 * hstepA, tstepB = 2 * hstepB;
    const unsigned ldsw = (unsigned)wid * 1024u;
    const int aoff = lds_byte(wr * 64 + fr, fq * 8), boff = lds_byte(wc * 32 + fr, fq * 8);
#define PG8_SA(b, h) (((b) * 2 + (h)) * HTB)
#define PG8_SB(b, h) ((4 + (b) * 2 + (h)) * HTB)
#define PG8_STAGE(bufoff, gbase, voff) do { _Pragma("unroll") for (int _i = 0; _i < 2; ++_i) \
        __builtin_amdgcn_global_load_lds((const unsigned*)((const char*)(gbase) + (voff)[_i]), (LAS unsigned*)(lds + (bufoff) + ldsw + _i * 8192), 16, 0, 0); } while (0)
#define PG8_LDA(dst, b, h) do { _Pragma("unroll") for (int m = 0; m < 4; ++m) _Pragma("unroll") for (int k = 0; k < 2; ++k) dst[m][k] = *(const LAS bf16x8*)(lds + PG8_SA(b, h) + aoff + m * 2048 + k * 1024); } while (0)
#define PG8_LDB(dst, b, h) do { _Pragma("unroll") for (int n = 0; n < 2; ++n) _Pragma("unroll") for (int k = 0; k < 2; ++k) dst[n][k] = *(const LAS bf16x8*)(lds + PG8_SB(b, h) + boff + n * 2048 + k * 1024); } while (0)
#define PG8_MMA(ai, bj, At, Bt) do { __builtin_amdgcn_s_setprio(1); _Pragma("unroll") for (int m = 0; m < 4; ++m) _Pragma("unroll") for (int n = 0; n < 2; ++n) _Pragma("unroll") for (int k = 0; k < 2; ++k) \
        acc[ai][bj][m][n] = __builtin_amdgcn_mfma_f32_16x16x32_bf16(Bt[n][k], At[m][k], acc[ai][bj][m][n], 0, 0, 0); __builtin_amdgcn_s_setprio(0); } while (0)
#define PG8_WAIT_V(n) asm volatile("s_waitcnt vmcnt(" #n ")" ::: "memory")
#define PG8_WAIT_L(n) asm volatile("s_waitcnt lgkmcnt(" #n ")" ::: "memory")
#define PG8_BAR __builtin_amdgcn_s_barrier()
#define PG8_SCHED __builtin_amdgcn_sched_barrier(0)
    Unit cur, nxt; int ui = 0;
    if (!S.next(0, cur)) return;
    f32x4 acc[2][2][4][2];
#pragma unroll
    for (int a = 0; a < 2; ++a)
#pragma unroll
        for (int b = 0; b < 2; ++b)
#pragma unroll
            for (int m = 0; m < 4; ++m)
#pragma unroll
                for (int n = 0; n < 2; ++n) acc[a][b][m][n] = (f32x4){0.f, 0.f, 0.f, 0.f};
    bf16x8 At[4][2], B0[2][2], B1[2][2];
    const char* cA = (const char*)g.A + (size_t)cur.pm * tstepA; const char* cB = (const char*)g.Bt + (size_t)cur.pn * tstepB;
    PG8_STAGE(PG8_SB(0, 0), cB, voffB); PG8_STAGE(PG8_SB(0, 1), cB + hstepB, voffB); PG8_STAGE(PG8_SA(0, 0), cA, voffA); PG8_STAGE(PG8_SA(0, 1), cA + hstepA, voffA);
    if (wr == 1) PG8_BAR;
    PG8_WAIT_V(2); PG8_BAR;
    PG8_STAGE(PG8_SB(1, 0), cB + kstep, voffB); PG8_STAGE(PG8_SA(1, 0), cA + kstep, voffA); PG8_STAGE(PG8_SB(1, 1), cB + hstepB + kstep, voffB);
    PG8_WAIT_V(6); PG8_BAR;
    for (;;) {
        const bool has_next = S.next(ui + 1, nxt);
        const char* nA = has_next ? (const char*)g.A + (size_t)nxt.pm * tstepA : cA; const char* nB = has_next ? (const char*)g.Bt + (size_t)nxt.pn * tstepB : cB;
        for (int t = 0; t < nt; t += 2) {
            const bool last = (t == nt - 2);
            const char* a1 = cA + (size_t)(t + 1) * kstep;
            const char* a2 = last ? nA : cA + (size_t)(t + 2) * kstep; const char* b2 = last ? nB : cB + (size_t)(t + 2) * kstep;
            const char* a3 = a2 + kstep; const char* b3 = b2 + kstep;
            PG8_LDB(B0, 0, 0); PG8_LDB(B1, 0, 1); PG8_SCHED; PG8_LDA(At, 0, 0); PG8_STAGE(PG8_SA(1, 1), a1 + hstepA, voffA);
            PG8_WAIT_V(8); PG8_WAIT_L(0); PG8_BAR; PG8_MMA(0, 0, At, B0); PG8_MMA(0, 1, At, B1); PG8_BAR; PG8_SCHED;
            PG8_LDA(At, 0, 1); PG8_STAGE(PG8_SB(0, 0), b2, voffB); PG8_STAGE(PG8_SB(0, 1), b2 + hstepB, voffB); PG8_STAGE(PG8_SA(0, 0), a2, voffA);
            PG8_WAIT_V(8); PG8_WAIT_L(0); PG8_BAR; PG8_MMA(1, 0, At, B0); PG8_MMA(1, 1, At, B1); PG8_BAR; PG8_SCHED;
            PG8_LDB(B0, 1, 0); PG8_LDB(B1, 1, 1); PG8_SCHED; PG8_LDA(At, 1, 0); PG8_STAGE(PG8_SA(0, 1), a2 + hstepA, voffA);
            PG8_WAIT_V(8); PG8_WAIT_L(0); PG8_BAR; PG8_MMA(0, 0, At, B0); PG8_MMA(0, 1, At, B1); PG8_BAR; PG8_SCHED;
            PG8_LDA(At, 1, 1); PG8_STAGE(PG8_SB(1, 0), b3, voffB); PG8_STAGE(PG8_SB(1, 1), b3 + hstepB, voffB); PG8_STAGE(PG8_SA(1, 0), a3, voffA);
            PG8_WAIT_V(8); PG8_WAIT_L(0); PG8_BAR; PG8_MMA(1, 0, At, B0); PG8_MMA(1, 1, At, B1); PG8_BAR; PG8_SCHED;
        }
        if (wr == 0) PG8_BAR;
        E(acc, cur, wr, wc, fr, fq);
        if (!has_next) break;
#pragma unroll
        for (int a = 0; a < 2; ++a)
#pragma unroll
            for (int b = 0; b < 2; ++b)
#pragma unroll
                for (int m = 0; m < 4; ++m)
#pragma unroll
                    for (int n = 0; n < 2; ++n) acc[a][b][m][n] = (f32x4){0.f, 0.f, 0.f, 0.f};
        cur = nxt; cA = nA; cB = nB; ++ui;
        if (wr == 1) PG8_BAR;
    }
    PG8_WAIT_V(0);
    PG8_BAR;
#undef PG8_SA
#undef PG8_SB
#undef PG8_STAGE
#undef PG8_LDA
#undef PG8_LDB
#undef PG8_MMA
#undef PG8_WAIT_V
#undef PG8_WAIT_L
#undef PG8_BAR
#undef PG8_SCHED
}
}
using pg8::Unit;
typedef const f32x4 (&AccRef)[2][2][4][2];

__device__ __forceinline__ u32x4 pack8(f32x4 a, f32x4 b) { u32x4 o; o.x = pk2(a[0], a[1]); o.y = pk2(a[2], a[3]); o.z = pk2(b[0], b[1]); o.w = pk2(b[2], b[3]); return o; }
__device__ __forceinline__ void unpack8(u32x4 v, f32x4& a, f32x4& b) { a[0] = bflo(v.x); a[1] = bfhi(v.x); a[2] = bflo(v.y); a[3] = bfhi(v.y); b[0] = bflo(v.z); b[1] = bfhi(v.z); b[2] = bflo(v.w); b[3] = bfhi(v.w); }

struct EpiStore {
    static constexpr bool PERM = true; bf16_t* O; int ldc;
    __device__ __forceinline__ void operator()(AccRef acc, const Unit& u, int wr, int wc, int fr, int fq) const {
        const int row0 = u.pm * 256 + wr * 64 + fr, col0 = u.pn * 256 + wc * 32 + 8 * fq;
#pragma unroll
        for (int ai = 0; ai < 2; ++ai)
#pragma unroll
            for (int m = 0; m < 4; ++m) { bf16_t* rowp = O + (size_t)(row0 + ai * 128 + m * 16) * ldc + col0;
#pragma unroll
                for (int bj = 0; bj < 2; ++bj) *(u32x4*)(rowp + bj * 128) = pack8(acc[ai][bj][m][0], acc[ai][bj][m][1]); }
    }
};
struct EpiSwiGLU {
    static constexpr bool PERM = true; bf16_t* O; int ldc;
    __device__ __forceinline__ void operator()(AccRef acc, const Unit& u, int wr, int wc, int fr, int fq) const {
        const int row0 = u.pm * 256 + wr * 64 + fr, col0 = u.pn * 128 + wc * 32 + 8 * fq;
#pragma unroll
        for (int ai = 0; ai < 2; ++ai)
#pragma unroll
            for (int m = 0; m < 4; ++m) { bf16_t* rowp = O + (size_t)(row0 + ai * 128 + m * 16) * ldc + col0;
                f32x4 a, b;
#pragma unroll
                for (int i = 0; i < 4; ++i) { a[i] = silu(acc[ai][0][m][0][i]) * acc[ai][1][m][0][i]; b[i] = silu(acc[ai][0][m][1][i]) * acc[ai][1][m][1][i]; }
                *(u32x4*)rowp = pack8(a, b); }
    }
};
struct EpiGLU {
    static constexpr bool PERM = true; bf16_t* O; const bf16_t* GA;
    __device__ __forceinline__ void operator()(AccRef acc, const Unit& u, int wr, int wc, int fr, int fq) const {
        const int row0 = u.pm * 256 + wr * 64 + fr, col0 = u.pn * 128 + wc * 32 + 8 * fq;
#pragma unroll
        for (int ai = 0; ai < 2; ++ai)
#pragma unroll
            for (int m = 0; m < 4; ++m) { const size_t off = (size_t)(row0 + ai * 128 + m * 16) * 2048 + col0;
                f32x4 g0, g1, a, b; unpack8(*(const u32x4*)(GA + off), g0, g1);
#pragma unroll
                for (int i = 0; i < 4; ++i) { a[i] = g0[i] * acc[ai][0][m][0][i] * sigm(acc[ai][1][m][0][i]); b[i] = g1[i] * acc[ai][0][m][1][i] * sigm(acc[ai][1][m][1][i]); }
                *(u32x4*)(O + off) = pack8(a, b); }
    }
};
struct EpiWo {
    static constexpr bool PERM = true; bf16_t* O; const bf16_t* GB;
    __device__ __forceinline__ void operator()(AccRef acc, const Unit& u, int wr, int wc, int fr, int fq) const {
        const int row0 = u.pm * 256 + wr * 64 + fr, col0 = u.pn * 256 + wc * 32 + 8 * fq;
#pragma unroll
        for (int ai = 0; ai < 2; ++ai)
#pragma unroll
            for (int m = 0; m < 4; ++m)
#pragma unroll
                for (int bj = 0; bj < 2; ++bj) { const size_t off = (size_t)(row0 + ai * 128 + m * 16) * 2048 + col0 + bj * 128;
                    f32x4 g0, g1, o0, o1, a, b; unpack8(*(const u32x4*)(GB + off), g0, g1); unpack8(*(const u32x4*)(O + off), o0, o1);
#pragma unroll
                    for (int i = 0; i < 4; ++i) { a[i] = o0[i] + g0[i] * acc[ai][bj][m][0][i]; b[i] = o1[i] + g1[i] * acc[ai][bj][m][1][i]; }
                    *(u32x4*)(O + off) = pack8(a, b); }
    }
};
struct EpiCmp {
    static constexpr bool PERM = true; bf16_t* O; const float* bias;
    __device__ __forceinline__ void operator()(AccRef acc, const Unit& u, int wr, int wc, int fr, int fq) const {
        const int row0 = u.pm * 256 + wr * 64 + fr, col0 = wc * 32 + 8 * fq;
#pragma unroll
        for (int bj = 0; bj < 2; ++bj) { const f32x4 b0 = *(const f32x4*)(bias + col0 + bj * 128), b1 = *(const f32x4*)(bias + col0 + bj * 128 + 4);
#pragma unroll
            for (int ai = 0; ai < 2; ++ai)
#pragma unroll
                for (int m = 0; m < 4; ++m) { f32x4 a, b;
#pragma unroll
                    for (int i = 0; i < 4; ++i) { a[i] = gelu_tanh(acc[ai][bj][m][0][i] + b0[i]); b[i] = gelu_tanh(acc[ai][bj][m][1][i] + b1[i]); }
                    *(u32x4*)(O + (size_t)(row0 + ai * 128 + m * 16) * 256 + col0 + bj * 128) = pack8(a, b); } }
    }
};
struct EpiIn {
    static constexpr bool PERM = true;
    bf16_t *USSM, *Q, *KV, *GA, *GB; float* GN;
    __device__ __forceinline__ void operator()(AccRef acc, const Unit& u, int wr, int wc, int fr, int fq) const {
        const int row0 = u.pm * 256 + wr * 64 + fr, cw = wc * 32 + 8 * fq; const int pn = u.pn;
        if (pn < 8) {
            bf16_t* base = pn < 4 ? USSM : Q; const float sc = pn < 4 ? 1.f : 0.18033688f  ; const int col0 = (pn & 3) * 256 + cw;
#pragma unroll
            for (int ai = 0; ai < 2; ++ai)
#pragma unroll
                for (int m = 0; m < 4; ++m) { bf16_t* rowp = base + (size_t)(row0 + ai * 128 + m * 16) * 1024 + col0;
#pragma unroll
                    for (int bj = 0; bj < 2; ++bj) *(u32x4*)(rowp + bj * 128) = pack8(acc[ai][bj][m][0] * sc, acc[ai][bj][m][1] * sc); }
        } else if (pn < 14) {
            const int kind = pn - 8; bf16_t* base = KV + (size_t)kind * ((size_t)MTOK * 256);
            const bool tr = (kind == 3) || (kind == 5);
#pragma unroll
            for (int ai = 0; ai < 2; ++ai)
#pragma unroll
                for (int m = 0; m < 4; ++m) { const int row = row0 + ai * 128 + m * 16, b = row >> 13, t = row & 8191;
#pragma unroll
                    for (int bj = 0; bj < 2; ++bj) { const int c = bj * 128 + cw, gg = c >> 6, d = c & 63;
                        if (!tr) *(u32x4*)(base + ((size_t)((b * 4 + gg) * SEQ + t)) * 64 + d) = pack8(acc[ai][bj][m][0], acc[ai][bj][m][1]);
                        else { bf16_t* p = base + ((size_t)((b * 4 + gg) * 64 + d)) * SEQ + t;
#pragma unroll
                            for (int i = 0; i < 4; ++i) { p[(size_t)i * SEQ] = (bf16_t)f2bf(acc[ai][bj][m][0][i]); p[(size_t)(4 + i) * SEQ] = (bf16_t)f2bf(acc[ai][bj][m][1][i]); } } } }
        } else if (pn < 30) {
            bf16_t* base = pn < 22 ? GA : GB; const int col0 = ((pn - 14) & 7) * 256 + cw;
#pragma unroll
            for (int ai = 0; ai < 2; ++ai)
#pragma unroll
                for (int m = 0; m < 4; ++m) { bf16_t* rowp = base + (size_t)(row0 + ai * 128 + m * 16) * 2048 + col0;
#pragma unroll
                    for (int bj = 0; bj < 2; ++bj) { f32x4 a, b;
#pragma unroll
                        for (int i = 0; i < 4; ++i) { a[i] = sigm(acc[ai][bj][m][0][i]); b[i] = sigm(acc[ai][bj][m][1][i]); }
                        *(u32x4*)(rowp + bj * 128) = pack8(a, b); } }
        } else {
            if (cw < 48) {
#pragma unroll
                for (int ai = 0; ai < 2; ++ai)
#pragma unroll
                    for (int m = 0; m < 4; ++m) { float* rowp = GN + (size_t)(row0 + ai * 128 + m * 16) * 48 + cw; f32x4 a, b;
#pragma unroll
                        for (int i = 0; i < 4; ++i) { a[i] = sigm(acc[ai][0][m][0][i]); b[i] = sigm(acc[ai][0][m][1][i]); }
                        *(f32x4*)rowp = a; *(f32x4*)(rowp + 4) = b; }
            }
        }
    }
};

__device__ __forceinline__ void tr_item(const float* __restrict__ W, int ldw, bf16_t* WT, int K, int k0, int src_col0, int nvalid, int dest_row0, LAS float* scr, int lane) {
    const int c = lane & 31;
    float wv[32];
#pragma unroll
    for (int i = 0; i < 32; ++i) { const int kk = 2 * i + (lane >> 5); wv[i] = (c < nvalid) ? W[(size_t)(k0 + kk) * ldw + src_col0 + c] : 0.f; }
#pragma unroll
    for (int i = 0; i < 32; ++i) { const int kk = 2 * i + (lane >> 5); scr[kk * 33 + c] = wv[i]; }
    LDS_WAIT();
    const int c8 = lane & 7;
#pragma unroll
    for (int j = 0; j < 4; ++j) { const int n = (lane >> 3) + 8 * j; const LAS float* s = scr + (8 * c8) * 33 + n;
        u32x4 o; o.x = pk2(s[0 * 33], s[1 * 33]); o.y = pk2(s[2 * 33], s[3 * 33]); o.z = pk2(s[4 * 33], s[5 * 33]); o.w = pk2(s[6 * 33], s[7 * 33]);
        *(u32x4*)(WT + (size_t)(dest_row0 + n) * K + k0 + 8 * c8) = o; }
    LDS_WAIT();
}
__device__ __forceinline__ void tr_job(const float* W, int ldw, int K, int nblk, bf16_t* WT, int item, int mode, LAS float* scr, int lane) {
    const int kb = item / nblk, nb = item - kb * nblk; int src = 32 * nb, dst = 32 * nb, nv = 32;
    if (mode == 1 || mode == 2) dst = (src >> 7) * 256 + (mode - 1) * 128 + (src & 127);
    else if (mode == 3) { if (dst < 3584) src = dst; else if (dst < 7680) src = dst + 48; else if (dst < 7712) src = 3584; else if (dst < 7744) { src = 3616; nv = 16; } else { src = 0; nv = 0; } }
    tr_item(W, ldw, WT, K, 64 * kb, src, nv, dst, scr, lane);
}

__device__ __forceinline__ void rowwise_row(const bf16_t* frow, const float* hin, float coef, const float* gpost, float* hout, const float* gpre, bf16_t* xn, int lane) {
    f32x4 f[4][2], h[4][2]; float ss = 0.f;
#pragma unroll
    for (int j = 0; j < 4; ++j) { unpack8(*(const u32x4*)(frow + 512 * j + 8 * lane), f[j][0], f[j][1]);
#pragma unroll
        for (int i = 0; i < 4; ++i) ss += f[j][0][i] * f[j][0][i] + f[j][1][i] * f[j][1][i]; }
    const float rs = coef * __frsqrt_rn(wave_sum(ss) * (1.f / DM) + EPS); float s2 = 0.f;
#pragma unroll
    for (int j = 0; j < 4; ++j)
#pragma unroll
        for (int q = 0; q < 2; ++q) { const int c = 512 * j + 8 * lane + 4 * q; const f32x4 hv = *(const f32x4*)(hin + c), gp = *(const f32x4*)(gpost + c);
            h[j][q] = hv + f[j][q] * rs * gp;
            if (xn) *(f32x4*)(hout + c) = h[j][q]; else __builtin_nontemporal_store(h[j][q], (f32x4*)(hout + c));
#pragma unroll
            for (int i = 0; i < 4; ++i) s2 += h[j][q][i] * h[j][q][i]; }
    if (xn) { const float r2 = __frsqrt_rn(wave_sum(s2) * (1.f / DM) + EPS);
#pragma unroll
        for (int j = 0; j < 4; ++j) { const int c = 512 * j + 8 * lane; const f32x4 g0 = *(const f32x4*)(gpre + c), g1 = *(const f32x4*)(gpre + c + 4);
            *(u32x4*)(xn + c) = pack8(h[j][0] * r2 * g0, h[j][1] * r2 * g1); } }
}
__device__ __forceinline__ void norm_row(const float* xrow, const float* g, bf16_t* xn, int lane) {
    f32x4 h[4][2]; float s2 = 0.f;
#pragma unroll
    for (int j = 0; j < 4; ++j)
#pragma unroll
        for (int q = 0; q < 2; ++q) { h[j][q] = *(const f32x4*)(xrow + 512 * j + 8 * lane + 4 * q);
#pragma unroll
            for (int i = 0; i < 4; ++i) s2 += h[j][q][i] * h[j][q][i]; }
    const float r2 = __frsqrt_rn(wave_sum(s2) * (1.f / DM) + EPS);
#pragma unroll
    for (int j = 0; j < 4; ++j) { const int c = 512 * j + 8 * lane; const f32x4 g0 = *(const f32x4*)(g + c), g1 = *(const f32x4*)(g + c + 4);
        *(u32x4*)(xn + c) = pack8(h[j][0] * r2 * g0, h[j][1] * r2 * g1); }
}

struct Params { const float* in[32]; float* out; unsigned char* ws; };


__device__ __forceinline__ bf16x8 pack_bf8(const float* p, float sgn) {
    const f32x4 a = *(const f32x4*)p, b = *(const f32x4*)(p + 4); u32x4 o; o.x = pk2(sgn * a[0], sgn * a[1]); o.y = pk2(sgn * a[2], sgn * a[3]); o.z = pk2(sgn * b[0], sgn * b[1]); o.w = pk2(sgn * b[2], sgn * b[3]);
    return __builtin_bit_cast(bf16x8, o);
}
__device__ __forceinline__ void s5_phase(LAS unsigned char* lds, const bf16_t* USSM, const float* S5A, const float* S5B, const float* c_re, const float* c_im, const float* dskip,
                                         bf16_t* YSSM, int tid, int lane, int wave) {
    LAS float* carry = (LAS float*)lds;
    LAS unsigned char* wb = lds + 4096 + wave * 13312;
    LAS float* BU = (LAS float*)wb;
    LAS bf16_t* XB = (LAS bf16_t*)(wb + 8448);
    LAS bf16_t* UST = (LAS bf16_t*)(wb + 8448 + 4352);
    const int r16 = lane & 15, q4 = lane >> 4;
    const f32x4 z4 = {0.f, 0.f, 0.f, 0.f};
    const bf16x8 zf = {0, 0, 0, 0, 0, 0, 0, 0};
    for (int bg = blockIdx.x; bg < 256; bg += gridDim.x) {
        const int b = bg >> 6, g = bg & 63;
        __syncthreads();
        const float are = S5A[(g * 64 + lane) * 2], aim = S5A[(g * 64 + lane) * 2 + 1];
        bf16x8 bfr[8], cfr[4];
#pragma unroll
        for (int nt = 0; nt < 8; ++nt) { const int pp = nt * 16 + r16, p = pp & 63, im = pp >> 6; bfr[nt] = q4 < 2 ? pack_bf8(S5B + (size_t)(g * 64 + p) * 32 + im * 16 + q4 * 8, 1.f) : zf; }
#pragma unroll
        for (int ks = 0; ks < 4; ++ks) { const int pp = ks * 32 + q4 * 8, p = pp & 63, im = pp >> 6; cfr[ks] = pack_bf8((im ? c_im : c_re) + (size_t)(g * 16 + r16) * 64 + p, im ? -1.f : 1.f); }
        const float dsk = dskip[g * 16 + r16];
        const bf16_t* ub = USSM + ((size_t)(b * SEQ + wave * 1024)) * 1024 + g * 16;
        float xr = 0.f, xi = 0.f;
        for (int tb = 0; tb < 64; ++tb) {
            bf16x8 a = *(const bf16x8*)(ub + (size_t)(tb * 16 + r16) * 1024 + (q4 & 1) * 8); if (q4 >= 2) a = zf;
#pragma unroll
            for (int nt = 0; nt < 8; ++nt) { const f32x4 acc = MFMA16(a, bfr[nt], z4);
#pragma unroll
                for (int i = 0; i < 4; ++i) BU[(q4 * 4 + i) * 132 + nt * 16 + r16] = acc[i]; }
            LDS_WAIT();
#pragma unroll
            for (int t = 0; t < 16; ++t) { const float br = BU[t * 132 + lane], bi = BU[t * 132 + 64 + lane];
                const float nr = are * xr - aim * xi + br, ni = are * xi + aim * xr + bi; xr = nr; xi = ni; }
            LDS_WAIT();
        }
        carry[(wave * 64 + lane) * 2] = xr; carry[(wave * 64 + lane) * 2 + 1] = xi;
        __syncthreads();
        float pr = are, pi = aim;
#pragma unroll
        for (int k = 0; k < 10; ++k) { const float t2 = pr * pr - pi * pi; pi = 2.f * pr * pi; pr = t2; }
        xr = 0.f; xi = 0.f;
        for (int k = 0; k < wave; ++k) { const float er = carry[(k * 64 + lane) * 2], ei = carry[(k * 64 + lane) * 2 + 1]; const float nr = pr * xr - pi * xi + er, ni = pr * xi + pi * xr + ei; xr = nr; xi = ni; }
        for (int tb = 0; tb < 64; ++tb) {
            bf16x8 a = *(const bf16x8*)(ub + (size_t)(tb * 16 + r16) * 1024 + (q4 & 1) * 8); *(LAS bf16x8*)(UST + r16 * 16 + (q4 & 1) * 8) = a; if (q4 >= 2) a = zf;
#pragma unroll
            for (int nt = 0; nt < 8; ++nt) { const f32x4 acc = MFMA16(a, bfr[nt], z4);
#pragma unroll
                for (int i = 0; i < 4; ++i) BU[(q4 * 4 + i) * 132 + nt * 16 + r16] = acc[i]; }
            LDS_WAIT();
#pragma unroll
            for (int t = 0; t < 16; ++t) { const float br = BU[t * 132 + lane], bi = BU[t * 132 + 64 + lane];
                const float nr = are * xr - aim * xi + br, ni = are * xi + aim * xr + bi; xr = nr; xi = ni;
                XB[t * 136 + lane] = tobf(xr); XB[t * 136 + 64 + lane] = tobf(xi); }
            LDS_WAIT();
            f32x4 y = z4;
#pragma unroll
            for (int ks = 0; ks < 4; ++ks) y = MFMA16(*(const LAS bf16x8*)(XB + r16 * 136 + ks * 32 + q4 * 8), cfr[ks], y);
#pragma unroll
            for (int i = 0; i < 4; ++i) { const float u = bflo((unsigned)UST[(q4 * 4 + i) * 16 + r16]); BU[(q4 * 4 + i) * 16 + r16] = gelu_tanh(y[i] + dsk * u); }
            LDS_WAIT();
            { const f32x4 v = *(const LAS f32x4*)(BU + (lane >> 2) * 16 + (lane & 3) * 4); u32x2 o; o.x = pk2(v[0], v[1]); o.y = pk2(v[2], v[3]);
              *(u32x2*)(YSSM + ((size_t)(b * SEQ + wave * 1024 + tb * 16 + (lane >> 2))) * 1024 + g * 16 + (lane & 3) * 4) = o; }
            LDS_WAIT();
        }
    }
    __syncthreads();
}

__device__ __forceinline__ void cmp2_phase(LAS unsigned char* lds, const bf16_t* H1K, const bf16_t* H1V, const float* w2k, const float* w2v, bf16_t* KCMP, bf16_t* VCMPT, int tid) {
    LAS float* w2s = (LAS float*)lds;
    for (int i = tid; i < 32768; i += NTHREADS) w2s[i] = i < 16384 ? w2k[i] : w2v[i - 16384];
    __syncthreads();
    const int d = tid & 63, rsub = tid >> 6;
    for (int rg = blockIdx.x; rg < 1024; rg += gridDim.x) {
        const int row = rg * 8 + rsub; const bf16_t* hk = H1K + (size_t)row * 256; const bf16_t* hv = H1V + (size_t)row * 256;
        float ak = 0.f, av = 0.f;
        for (int n = 0; n < 256; n += 8) { f32x4 k0, k1, v0, v1; unpack8(*(const u32x4*)(hk + n), k0, k1); unpack8(*(const u32x4*)(hv + n), v0, v1);
#pragma unroll
            for (int j = 0; j < 4; ++j) { ak += k0[j] * w2s[(n + j) * 64 + d] + k1[j] * w2s[(n + 4 + j) * 64 + d]; av += v0[j] * w2s[16384 + (n + j) * 64 + d] + v1[j] * w2s[16384 + (n + 4 + j) * 64 + d]; } }
        const int bgi = row >> 9, i = row & 511; const bool ok = i < 511;
        KCMP[(size_t)row * 64 + d] = ok ? (bf16_t)f2bf(ak) : (bf16_t)0;
        VCMPT[((size_t)(bgi * 64 + d)) * 512 + i] = ok ? (bf16_t)f2bf(av) : (bf16_t)0;
    }
    __syncthreads();
}

__device__ __forceinline__ float red16(float v) { v += __shfl_xor(v, 1); v += __shfl_xor(v, 2); v += __shfl_xor(v, 4); v += __shfl_xor(v, 8); return v; }
__device__ __forceinline__ int clampd(int d) { return d < 0 ? 0 : (d > 1024 ? 1024 : d); }

__device__ __forceinline__ float ex2(float x) { return __builtin_amdgcn_exp2f(x); }
struct KFrag { bf16x8 k[4][2]; };
struct VFrag { bf16x8 v[2][4]; };
__device__ __forceinline__ void load_k(KFrag& f, const char* kb, unsigned koffB) {
#pragma unroll
    for (int cc = 0; cc < 4; ++cc) { f.k[cc][0] = *(const bf16x8*)(kb + cc * 2048 + koffB); f.k[cc][1] = *(const bf16x8*)(kb + cc * 2048 + 64 + koffB); }
}
__device__ __forceinline__ void load_v(VFrag& f, const char* vb, unsigned voffB, int vstride) {
#pragma unroll
    for (int ks = 0; ks < 2; ++ks)
#pragma unroll
        for (int nt = 0; nt < 4; ++nt) f.v[ks][nt] = *(const bf16x8*)(vb + (size_t)nt * 32 * vstride + ks * 64 + voffB);
}
__device__ __forceinline__ void pv_step(const VFrag& f, f32x4 (&o)[4], const LAS bf16_t* Pb, int r16, int q4) {
    CBAR();
#pragma unroll
    for (int ks = 0; ks < 2; ++ks) { const bf16x8 aP = *(const LAS bf16x8*)(Pb + r16 * 72 + ks * 32 + q4 * 8);
#pragma unroll
        for (int nt = 0; nt < 4; ++nt) o[nt] = MFMA16(aP, f.v[ks][nt], o[nt]); }
    CBAR();
}
__device__ __forceinline__ void qk_scores(const KFrag& f, const LAS bf16_t* qf, f32x4 (&sc)[4]) {
    const f32x4 z4 = {0.f, 0.f, 0.f, 0.f};
    const bf16x8 aq0 = *(const LAS bf16x8*)qf, aq1 = *(const LAS bf16x8*)(qf + 512);
#pragma unroll
    for (int cc = 0; cc < 4; ++cc) { sc[cc] = MFMA16(aq0, f.k[cc][0], z4); sc[cc] = MFMA16(aq1, f.k[cc][1], sc[cc]); }
}
template <int TT> __device__ __forceinline__ void sel_sm(const f32x4 (&sc)[4], int j, int tok, const LAS float* bt, LAS bf16_t* Pb, float& lsum, int r16, int q4) {
#pragma unroll
    for (int cc = 0; cc < 4; ++cc) {
        const int dist = tok - (64 * j + cc * 16 + r16);
        const float p = dist >= 0 ? ex2(sc[cc][TT] + bt[clampd(dist)]) : 0.f; lsum += p;
        Pb[(4 * q4 + TT) * 72 + cc * 16 + r16] = tobf(p);
    }
}
__device__ __forceinline__ void win_sm(const f32x4 (&sc)[4], int gr, int t0, const LAS float* bt, LAS bf16_t* Pb, float (&lw)[4], int r16, int q4) {
#pragma unroll
    for (int cc = 0; cc < 4; ++cc) {
        const int pos = gr * 64 + cc * 16 + r16;
#pragma unroll
        for (int i = 0; i < 4; ++i) { const int dist = t0 + i - pos; const float p = ((unsigned)dist < 512u) ? ex2(sc[cc][i] + bt[clampd(dist)]) : 0.f; lw[i] += p; Pb[(4 * q4 + i) * 72 + cc * 16 + r16] = tobf(p); }
    }
}
__device__ __forceinline__ void cmp_sm1(const f32x4 (&sc)[4], int gr, int t0, const LAS float* bt, float (&ls)[4], int r16) {
#pragma unroll
    for (int cc = 0; cc < 4; ++cc) {
        const int cend = (gr * 64 + cc * 16 + r16) * 16 + 31;
#pragma unroll
        for (int i = 0; i < 4; ++i) { const int dist = t0 + i - cend; ls[i] += dist >= 0 ? ex2(sc[cc][i] + bt[clampd(dist)]) : 0.f; }
    }
}
__device__ __forceinline__ void cmp_sm2(const f32x4 (&sc)[4], int gr, int t0, const LAS float* bt, const float (&inv)[4], LAS bf16_t* Pb, LAS float* psum, int r16, int q4) {
#pragma unroll
    for (int cc = 0; cc < 4; ++cc) {
        const int kk = gr * 64 + cc * 16 + r16, cend = kk * 16 + 31;
#pragma unroll
        for (int i = 0; i < 4; ++i) { const int dist = t0 + i - cend; float p = dist >= 0 ? ex2(sc[cc][i] + bt[clampd(dist)]) * inv[i] : 0.f;
            Pb[(4 * q4 + i) * 72 + cc * 16 + r16] = tobf(p); p += __shfl_xor(p, 16); p += __shfl_xor(p, 32); if (q4 == 0) psum[i * 512 + kk] = p; }
    }
}

__device__ __forceinline__ void nsa_quad_pre(int bg, int quad, const bf16_t* Q, const bf16_t* KV, const bf16_t* KCMP, const bf16_t* VCMPT, const float* GN, bf16_t* ONSA,
                                             const LAS float* btab, LAS bf16_t* Pb, LAS float* psum, LAS int* selq, LAS bf16_t* qfw, int lane) {
    const int r16 = lane & 15, q4 = lane >> 4, b = bg >> 2, g = bg & 3, t0 = quad * 4;
    const unsigned koff = (unsigned)(r16 * 64 + q4 * 8) * 2u, voffS = (unsigned)(r16 * SEQ + q4 * 8) * 2u, voffC = (unsigned)(r16 * 512 + q4 * 8) * 2u;
    const char* KWb = (const char*)(KV + 4 * (size_t)MTOK * 256 + (size_t)bg * SEQ * 64); const char* VWb = (const char*)(KV + 5 * (size_t)MTOK * 256 + (size_t)bg * 64 * SEQ);
    const char* KCb = (const char*)(KCMP + (size_t)bg * 512 * 64); const char* VCb = (const char*)(VCMPT + (size_t)bg * 64 * 512);
#define KP_C(i) KCb + (i) * 8192, koff
#define VP_C(i) VCb + (i) * 128, voffC, 512
#define KP_W(i) KWb + (i) * 8192, koff
#define VP_W(i) VWb + (i) * 128, voffS, SEQ
    const size_t qoff = (size_t)(b * SEQ + t0 + (r16 & 3)) * 1024 + (g * 4 + (r16 >> 2)) * 64 + q4 * 8;
    { const bf16x8 a0 = *(const bf16x8*)(Q + qoff), a1 = *(const bf16x8*)(Q + qoff + 32); *(LAS bf16x8*)(qfw + lane * 8) = a0; *(LAS bf16x8*)(qfw + 512 + lane * 8) = a1; }
    const LAS bf16_t* qf = qfw + lane * 8;
    const LAS float* bt = btab + q4 * 1028;
    const f32x4 z4 = {0.f, 0.f, 0.f, 0.f};
    KFrag KF; VFrag VF; f32x4 sc[4];
    const int w_lo = (t0 - 511 > 0 ? t0 - 511 : 0) >> 6, w_hi = t0 >> 6;
    f32x4 oc[4] = {z4, z4, z4, z4};
    const int tl = t0 + 3, nvmax = tl >= 31 ? ((tl - 31) >> 4) + 1 : 0, ngr = (nvmax + 63) >> 6;
    if (ngr > 0) {
        float ls[4] = {0.f, 0.f, 0.f, 0.f};
        load_k(KF, KP_C(0));
        for (int gr = 0; gr < ngr; ++gr) {
            qk_scores(KF, qf, sc);
            load_k(KF, KP_C(gr + 1 < ngr ? gr + 1 : 0));
            cmp_sm1(sc, gr, t0, bt, ls, r16);
        }
        load_v(VF, VP_C(0));
        float inv[4];
#pragma unroll
        for (int i = 0; i < 4; ++i) { const float l = red16(ls[i]); inv[i] = l > 0.f ? 1.f / l : 0.f; }
        for (int gr = 0; gr < ngr; ++gr) {
            const bool more = gr + 1 < ngr;
            qk_scores(KF, qf, sc);
            if (more) load_k(KF, KP_C(gr + 1));
            cmp_sm2(sc, gr, t0, bt, inv, Pb, psum, r16, q4);
            pv_step(VF, oc, Pb, r16, q4);
            if (more) load_v(VF, VP_C(gr + 1));
        }
    }
    CBAR();
#pragma unroll
    for (int tt = 0; tt < 4; ++tt) {
        const int tok = t0 + tt, cur = tok >> 6;
        if (cur < 16) { if (lane < 16) selq[tt * 16 + lane] = lane; }
        else {
            unsigned k0 = 0u, k1 = 0u;
            { const int j = lane; if (j >= 1 && j <= cur - 2) { const LAS float* ps = psum + tt * 512 + 4 * j - 1; const float v = ps[0] + ps[1] + ps[2] + ps[3] + ps[4]; k0 = (__builtin_bit_cast(unsigned, v) & ~127u) | (unsigned)(127 - j); } }
            { const int j = lane + 64; if (j <= cur - 2) { const LAS float* ps = psum + tt * 512 + 4 * j - 1; const float v = ps[0] + ps[1] + ps[2] + ps[3] + ps[4]; k1 = (__builtin_bit_cast(unsigned, v) & ~127u) | (unsigned)(127 - j); } }
            for (int it = 0; it < 13; ++it) {
                unsigned m = k0 > k1 ? k0 : k1;
#pragma unroll
                for (int off = 32; off >= 1; off >>= 1) { const unsigned o = (unsigned)__shfl_xor((int)m, off); m = o > m ? o : m; }
                if (k0 == m) k0 = 0u; if (k1 == m) k1 = 0u;
                if (lane == 0) selq[tt * 16 + it] = 127 - (int)(m & 127u);
            }
            if (lane == 0) { selq[tt * 16 + 13] = 0; selq[tt * 16 + 14] = cur - 1; selq[tt * 16 + 15] = cur; }
        }
    }
    CBAR();
#pragma unroll
    for (int tt = 0; tt < 4; ++tt) { const float gc = GN[(size_t)(b * SEQ + t0 + tt) * 48 + (g * 4 + q4) * 3];
        bf16_t* op = ONSA + (size_t)(b * SEQ + t0 + tt) * 1024 + (g * 4 + q4) * 64 + r16;
#pragma unroll
        for (int nt = 0; nt < 4; ++nt) op[nt * 16] = tobf(gc * oc[nt][tt]); }
#undef KP_C
#undef VP_C
#undef KP_W
#undef VP_W
}

template <int MODE>
__device__ __forceinline__ void nsa_block_loop(int bg, int qb, const bf16_t* Q, const bf16_t* KV, const float* GN, bf16_t* ONSA, const LAS float* btab, LAS bf16_t* Pb,
                                               const LAS int* selall, LAS unsigned* masks, LAS bf16_t* stage, int tid, int lane, int wave) {
    const int r16 = lane & 15, q4 = lane >> 4, b = bg >> 2, g = bg & 3;
    const bf16_t* Kt = KV + (MODE ? 4 : 2) * (size_t)MTOK * 256 + (size_t)bg * SEQ * 64; const bf16_t* Vt = KV + (MODE ? 5 : 3) * (size_t)MTOK * 256 + (size_t)bg * 64 * SEQ;
    const LAS float* bt = btab + q4 * 1028;
    const float bfar = bt[1024];
    const f32x4 z4 = {0.f, 0.f, 0.f, 0.f};
    const int j0 = MODE ? (qb - 8 > 0 ? qb - 8 : 0) : 0;
    if (MODE == 0 && tid < 256) { const int tok = tid >> 2, word = tid & 3; unsigned m = 0u;
        if (qb < 16) m = word == 0 ? ((2u << qb) - 1u) : 0u;
        else {
#pragma unroll
            for (int n = 0; n < 16; ++n) { const int j = selall[tok * 16 + n]; m |= ((j >> 5) == word) ? (1u << (j & 31)) : 0u; } }
        masks[tid] = m; }
    bf16x8 aq[2][2];
#pragma unroll
    for (int tile = 0; tile < 2; ++tile) { const int t0 = qb * 64 + wave * 8 + tile * 4;
        const size_t qoff = (size_t)(b * SEQ + t0 + (r16 & 3)) * 1024 + (g * 4 + (r16 >> 2)) * 64 + q4 * 8;
        aq[tile][0] = *(const bf16x8*)(Q + qoff); aq[tile][1] = *(const bf16x8*)(Q + qoff + 32); }
    f32x4 os[2][4]; float ls[2][4];
#pragma unroll
    for (int tile = 0; tile < 2; ++tile)
#pragma unroll
        for (int i = 0; i < 4; ++i) { os[tile][i] = z4; ls[tile][i] = 0.f; }
    const int srow = tid >> 3, sch = tid & 7, soff = srow * 72 + sch * 8;
    const unsigned kgo = (unsigned)(srow * 64 + sch * 8) * 2u, vgo = (unsigned)(srow * SEQ + sch * 8) * 2u;
#define NSA_LD1(jj) do { kr = *(const bf16x8*)((const char*)Kt + (size_t)(jj) * 8192 + kgo); vr = *(const bf16x8*)((const char*)Vt + (jj) * 128 + vgo); } while (0)
#define NSA_ST1(st_, half_) do { LAS bf16_t* nx_ = stage + (st_) * 18432 + (half_) * 9216 + soff; *(LAS bf16x8*)nx_ = kr; *(LAS bf16x8*)(nx_ + 4608) = vr; } while (0)
    bf16x8 kr, vr;
    NSA_LD1(j0); NSA_ST1(0, 0);
    if (j0 + 1 <= qb) { NSA_LD1(j0 + 1); NSA_ST1(0, 1); }
    __syncthreads();
    for (int jA = j0, pp = 0; jA <= qb; jA += 2, pp ^= 1) {
      for (int sub = 0; sub < 2; ++sub) {
        const int j = jA + sub; if (j > qb) break;
        const bool pre = j + 2 <= qb;
        if (pre) NSA_LD1(j + 2);
        const LAS bf16_t* Ks = stage + pp * 18432 + sub * 9216; const LAS bf16_t* Vs = Ks + 4608;
        const bool far = MODE == 0 && (qb - j >= 17);
#pragma unroll
        for (int tile = 0; tile < 2; ++tile) {
            const int tl0 = wave * 8 + tile * 4, t0 = qb * 64 + tl0;
            unsigned mb[4] = {1u, 1u, 1u, 1u};
            if (MODE == 0) {
#pragma unroll
                for (int i = 0; i < 4; ++i) mb[i] = (masks[(tl0 + i) * 4 + (j >> 5)] >> (j & 31)) & 1u; }
            if (MODE == 1 || __builtin_amdgcn_readfirstlane((int)(mb[0] | mb[1] | mb[2] | mb[3]))) {
                f32x4 sc[4];
#pragma unroll
                for (int cc = 0; cc < 4; ++cc) { const LAS bf16_t* kp = Ks + (cc * 16 + r16) * 72 + q4 * 8;
                    sc[cc] = MFMA16(aq[tile][0], *(const LAS bf16x8*)kp, z4); sc[cc] = MFMA16(aq[tile][1], *(const LAS bf16x8*)(kp + 32), sc[cc]); }
                if (far) {
#pragma unroll
                    for (int cc = 0; cc < 4; ++cc)
#pragma unroll
                        for (int i = 0; i < 4; ++i) { const float p = mb[i] ? ex2(sc[cc][i] + bfar) : 0.f; ls[tile][i] += p; Pb[(4 * q4 + i) * 72 + cc * 16 + r16] = tobf(p); }
                } else {
#pragma unroll
                    for (int cc = 0; cc < 4; ++cc) { const int pos = j * 64 + cc * 16 + r16;
#pragma unroll
                        for (int i = 0; i < 4; ++i) { const int dist = t0 + i - pos; const bool ok = MODE ? ((unsigned)dist < 512u) : (dist >= 0 && mb[i]);
                            const float p = ok ? ex2(sc[cc][i] + bt[clampd(dist)]) : 0.f; ls[tile][i] += p; Pb[(4 * q4 + i) * 72 + cc * 16 + r16] = tobf(p); } }
                }
                CBAR();
#pragma unroll
                for (int ks = 0; ks < 2; ++ks) { const bf16x8 aP = *(const LAS bf16x8*)(Pb + r16 * 72 + ks * 32 + q4 * 8);
#pragma unroll
                    for (int nt = 0; nt < 4; ++nt) os[tile][nt] = MFMA16(aP, *(const LAS bf16x8*)(Vs + (nt * 16 + r16) * 72 + ks * 32 + q4 * 8), os[tile][nt]); }
                CBAR();
            }
        }
        if (pre) NSA_ST1(pp ^ 1, sub);
      }
        __syncthreads();
    }
#undef NSA_LD1
#undef NSA_ST1
#pragma unroll
    for (int tile = 0; tile < 2; ++tile) { const int t0 = qb * 64 + wave * 8 + tile * 4;
#pragma unroll
        for (int tt = 0; tt < 4; ++tt) { const float gs = GN[(size_t)(b * SEQ + t0 + tt) * 48 + (g * 4 + q4) * 3 + (MODE ? 2 : 1)] / red16(ls[tile][tt]);
            bf16_t* op = ONSA + (size_t)(b * SEQ + t0 + tt) * 1024 + (g * 4 + q4) * 64 + r16;
#pragma unroll
            for (int nt = 0; nt < 4; ++nt) op[nt * 16] = tobf(bflo((unsigned)op[nt * 16]) + gs * os[tile][nt][tt]); } }
}

__device__ __forceinline__ int t5_bucket(int d) {
    if (d < 16) return d;
    if (d >= 1024) return 31;
    int k = 0;
    k += d >= 21; k += d >= 27; k += d >= 35; k += d >= 46; k += d >= 59; k += d >= 77; k += d >= 99; k += d >= 128;
    k += d >= 166; k += d >= 216; k += d >= 280; k += d >= 363; k += d >= 470; k += d >= 609; k += d >= 790;
    return 16 + k;
}
__device__ __forceinline__ void nsa_phase(LAS unsigned char* lds, const bf16_t* Q, const bf16_t* KV, const bf16_t* KCMP, const bf16_t* VCMPT, const float* GN, const float* rel_bias, bf16_t* ONSA,
                                          int tid, int lane, int wave) {
    LAS float* btab = (LAS float*)lds;
    LAS bf16_t* Pb = (LAS bf16_t*)(lds + 16448 + wave * 2304);
    LAS bf16_t* qfw = (LAS bf16_t*)(lds + 34880 + wave * 2048);
    LAS int* selall = (LAS int*)(lds + 51264);
    LAS unsigned* masks = (LAS unsigned*)(lds + 55360);
    LAS float* psum = (LAS float*)(lds + 56384 + wave * 8192);
    LAS bf16_t* stage = (LAS bf16_t*)(lds + 56384);
    for (int i = lane; i < 576; i += 64) ((LAS unsigned*)Pb)[i] = 0u;
    for (int vb = blockIdx.x; vb < 256; vb += gridDim.x) {
        const int xcd = vb & 7, idx = vb >> 3;
        for (int pass = 0; pass < 2; ++pass) {
            const int bg = xcd + 8 * pass, g = bg & 3;
            __syncthreads();
            for (int i2 = tid; i2 < 4 * 1025; i2 += NTHREADS) { const int hh = i2 / 1025, dd = i2 - hh * 1025; btab[hh * 1028 + dd] = 1.44269504089f * rel_bias[t5_bucket(dd) * 16 + g * 4 + hh]; }
            __syncthreads();
            for (int kk = 0; kk < 4; ++kk) {
                const int qb = (kk & 1) ? (32 * kk + 31 - idx) : (32 * kk + idx);
                nsa_quad_pre(bg, qb * 16 + wave * 2, Q, KV, KCMP, VCMPT, GN, ONSA, btab, Pb, psum, selall + (wave * 2) * 64, qfw, lane);
                nsa_quad_pre(bg, qb * 16 + wave * 2 + 1, Q, KV, KCMP, VCMPT, GN, ONSA, btab, Pb, psum, selall + (wave * 2 + 1) * 64, qfw, lane);
                __syncthreads();
                nsa_block_loop<0>(bg, qb, Q, KV, GN, ONSA, btab, Pb, selall, masks, stage, tid, lane, wave);
                nsa_block_loop<1>(bg, qb, Q, KV, GN, ONSA, btab, Pb, selall, masks, stage, tid, lane, wave);
            }
        }
    }
    __syncthreads();
}

#define XB_TMO      128
#define XB_XCNT(j)  (256  + 64 * (j))
#define XB_XSUB(j)  (1280 + 64 * (j))
#define XB_XGEN(j)  (2304 + 64 * (j))
#define XB_TOP      3328
#define XB_TOPGEN   3392
#define XCD_BAR_WORDS 3456
#define XB_SPIN_CAP (1u << 18)

__device__ __forceinline__ unsigned xb_ld(unsigned* p)              { return __hip_atomic_load(p, __ATOMIC_RELAXED, __HIP_MEMORY_SCOPE_AGENT); }
__device__ __forceinline__ unsigned xb_add(unsigned* p, unsigned v) { return __hip_atomic_fetch_add(p, v, __ATOMIC_RELAXED, __HIP_MEMORY_SCOPE_AGENT); }
__device__ __forceinline__ unsigned xb_xcc_id() { return (unsigned)__builtin_amdgcn_s_getreg((3 << 11) | 20) & 0xFu; }
#define XB_SPIN(cond, bar) do { unsigned _sp = 0; while (cond) { __builtin_amdgcn_s_sleep(1); \
    if ((++_sp & 255u) == 0u) { if (xb_ld(&(bar)[XB_TMO])) break; if (_sp > XB_SPIN_CAP) { atomicAdd(&(bar)[XB_TMO], 1u); break; } } } } while (0)

struct XcdBarrier {
    unsigned* bar; unsigned x;
    volatile LAS unsigned* st;
};

__device__ __forceinline__ XcdBarrier xcd_barrier_post(unsigned* bar, volatile LAS unsigned* st) {
    XcdBarrier b; b.bar = bar; b.x = xb_xcc_id(); b.st = st;
    if (threadIdx.x == 0) (void)xb_add(&bar[XB_XCNT(b.x)], 1u);
    return b;
}
__device__ __forceinline__ void xcd_barrier_complete(unsigned* bar, unsigned x, unsigned& nloc, unsigned& nx) {
    const unsigned G = gridDim.x * gridDim.y * gridDim.z;
    unsigned sum, cnt, mine, sp = 0u;
    for (;;) {
        sum = 0u; cnt = 0u; mine = 0u;
#pragma unroll
        for (unsigned j = 0; j < 16; ++j) { const unsigned c = xb_ld(&bar[XB_XCNT(j)]); sum += c; cnt += (c > 0u) ? 1u : 0u; mine = (j == x) ? c : mine; }
        if (sum == G) break;
        __builtin_amdgcn_s_sleep(1);
        if ((++sp & 255u) == 0u) { if (xb_ld(&bar[XB_TMO])) break; if (sp > XB_SPIN_CAP) { atomicAdd(&bar[XB_TMO], 1u); break; } }
    }
    nloc = mine > 0u ? mine : 1u; nx = cnt > 0u ? cnt : 1u;
}

__device__ __forceinline__ void xcd_barrier(const XcdBarrier& b) {
    asm volatile("s_waitcnt vmcnt(0)" ::: "memory");
    __syncthreads();
    if (threadIdx.x == 0) {
        unsigned* bar = b.bar;
        __builtin_amdgcn_s_waitcnt(0);
        unsigned nloc = b.st[0], nx = b.st[1];
        if (nloc == 0u) { xcd_barrier_complete(bar, b.x, nloc, nx); b.st[0] = nloc; b.st[1] = nx; }
        const unsigned old = xb_add(&bar[XB_XSUB(b.x)], 1u);
        const unsigned gen = old / nloc;
        if (old + 1u == (gen + 1u) * nloc) {
            __builtin_amdgcn_fence(__ATOMIC_RELEASE, "agent");
            asm volatile("s_waitcnt vmcnt(0)" ::: "memory");
            const unsigned og = xb_add(&bar[XB_TOP], 1u);
            const unsigned tg = og / nx;
            if (og + 1u == (tg + 1u) * nx) xb_add(&bar[XB_TOPGEN], 1u);
            else XB_SPIN(xb_ld(&bar[XB_TOPGEN]) == tg, bar);
            __builtin_amdgcn_fence(__ATOMIC_ACQUIRE, "agent");
            xb_add(&bar[XB_XGEN(b.x)], 1u);
            asm volatile("s_waitcnt vmcnt(0)" ::: "memory");
        } else {
            XB_SPIN(xb_ld(&bar[XB_XGEN(b.x)]) == gen, bar);
            __builtin_amdgcn_fence(__ATOMIC_ACQUIRE, "agent");
            asm volatile("s_waitcnt vmcnt(0)" ::: "memory");
        }
    }
    __syncthreads();
}


__global__ void __launch_bounds__(NTHREADS, 2) fwd_kernel(Params P) {
    extern __shared__ __attribute__((aligned(16))) unsigned char lds_raw[];
    LAS unsigned char* lds = (LAS unsigned char*)lds_raw;
    cg::grid_group grid = cg::this_grid();
    int tid = threadIdx.x, lane = tid & 63, wave = __builtin_amdgcn_readfirstlane(tid >> 6);
    const int G = gridDim.x, NGW = G * 8; int gw = blockIdx.x * 8 + wave;
#define REIDS() do { tid = threadIdx.x; asm volatile("" : "+v"(tid)); lane = tid & 63; wave = __builtin_amdgcn_readfirstlane(tid >> 6); gw = blockIdx.x * 8 + wave; } while (0)
    ((LAS int*)(lds + 145408))[tid] = tid; if (tid < 2) ((LAS unsigned*)(lds + 131072))[tid] = 0u; __syncthreads();
    const XcdBarrier xbar = xcd_barrier_post((unsigned*)(P.ws + WS_BAR), (volatile LAS unsigned*)(lds + 131072));
    unsigned char* ws = P.ws;
    bf16_t* W1GU = (bf16_t*)(ws + WS_W1GU); bf16_t* W1D = (bf16_t*)(ws + WS_W1D); bf16_t* W2GU = (bf16_t*)(ws + WS_W2GU); bf16_t* W2D = (bf16_t*)(ws + WS_W2D);
    bf16_t* WIN = (bf16_t*)(ws + WS_WIN); bf16_t* WGLU = (bf16_t*)(ws + WS_WGLU); bf16_t* WO = (bf16_t*)(ws + WS_WO); bf16_t* WOUT = (bf16_t*)(ws + WS_WOUT);
    bf16_t* CKW1 = (bf16_t*)(ws + WS_CKW1); bf16_t* CVW1 = (bf16_t*)(ws + WS_CVW1);
    bf16_t* XN = (bf16_t*)(ws + WS_XN); bf16_t* ACT = (bf16_t*)(ws + WS_ACT); bf16_t* FB = (bf16_t*)(ws + WS_F); bf16_t* KV = (bf16_t*)(ws + WS_KV);
    bf16_t* YSSM = XN; bf16_t* ONSA = XN + (size_t)MTOK * 1024;
    bf16_t* GA = ACT; bf16_t* GB = ACT + (size_t)MTOK * 2048; bf16_t* USSM = ACT + (size_t)MTOK * 4096; bf16_t* MIXED = ACT;
    bf16_t* QB = FB; bf16_t* MERGED = FB;
    bf16_t* H1K = (bf16_t*)(ws + WS_H1K); bf16_t* H1V = (bf16_t*)(ws + WS_H1V); bf16_t* KCMP = (bf16_t*)(ws + WS_KCMP); bf16_t* VCMPT = (bf16_t*)(ws + WS_VCMPT);
    float* GN = (float*)(ws + WS_GN); float* S5A = (float*)(ws + WS_S5A); float* S5B = (float*)(ws + WS_S5B); float* CB = (float*)(ws + WS_CB);
    const float* x = P.in[0]; float* out = P.out;

    {
        LAS float* scr = (LAS float*)(lds + wave * 16384);
        constexpr int I_FF = 5632, I_IN = 7936, I_GL = 1024, I_OUT = 2048, I_C = 256;
        constexpr int NITEMS = 6 * I_FF + I_IN + 3 * I_GL + I_OUT + 2 * I_C;
        for (int it = gw; it < NITEMS; it += NGW) {
            int r = it;
            if (r < I_FF) { tr_job(P.in[2], DFF, DM, 176, W1GU, r, 1, scr, lane); continue; } r -= I_FF;
            if (r < I_FF) { tr_job(P.in[3], DFF, DM, 176, W1GU, r, 2, scr, lane); continue; } r -= I_FF;
            if (r < I_FF) { tr_job(P.in[4], DM, DFF, 64, W1D, r, 0, scr, lane); continue; } r -= I_FF;
            if (r < I_FF) { tr_job(P.in[27], DFF, DM, 176, W2GU, r, 1, scr, lane); continue; } r -= I_FF;
            if (r < I_FF) { tr_job(P.in[28], DFF, DM, 176, W2GU, r, 2, scr, lane); continue; } r -= I_FF;
            if (r < I_FF) { tr_job(P.in[29], DM, DFF, 64, W2D, r, 0, scr, lane); continue; } r -= I_FF;
            if (r < I_IN) { tr_job(P.in[7], 7728, DM, 248, WIN, r, 3, scr, lane); continue; } r -= I_IN;
            if (r < I_GL) { tr_job(P.in[16], 2048, 1024, 64, WGLU, r, 1, scr, lane); continue; } r -= I_GL;
            if (r < I_GL) { tr_job(P.in[17], 2048, 1024, 64, WGLU, r, 2, scr, lane); continue; } r -= I_GL;
            if (r < I_GL) { tr_job(P.in[23], 2048, 1024, 64, WO, r, 0, scr, lane); continue; } r -= I_GL;
            if (r < I_OUT) { tr_job(P.in[24], 2048, 2048, 64, WOUT, r, 0, scr, lane); continue; } r -= I_OUT;
            if (r < I_C) { tr_job(P.in[19], 256, 2048, 8, CKW1, r, 0, scr, lane); continue; } r -= I_C;
            tr_job(P.in[21], 256, 2048, 8, CVW1, r, 0, scr, lane);
        }
        for (int m = gw; m < MTOK; m += NGW) norm_row(x + (size_t)m * DM, P.in[1], XN + (size_t)m * DM, lane);
        const int gid = blockIdx.x * NTHREADS + tid;
        if (gid < 4096) {
            const int g = gid >> 6;
            const float dt = expf(P.in[10][g]); const float lre = fminf(P.in[8][gid], -1e-4f), lim = P.in[9][gid];
            const float mag = expf(lre * dt);
            double th = (double)lim * (double)dt; th -= 6.283185307179586476925 * rint(th * 0.15915494309189533577); const double t2 = th * th;
            double sn = 1.0, cs = 1.0;
            { double term = 1.0; double s = 0.0, c = 0.0; for (int k = 0; k < 14; ++k) { c += term; term *= th / (double)(2 * k + 1); s += term; term *= -th / (double)(2 * k + 2); } sn = s; cs = c; (void)t2; }
            const float are = mag * (float)cs, aim = mag * (float)sn;
            const float den = lre * lre + lim * lim, nre = are - 1.f, nim = aim;
            const float cre = (nre * lre + nim * lim) / den, cim = (nim * lre - nre * lim) / den;
            S5A[gid * 2] = are; S5A[gid * 2 + 1] = aim;
            for (int c = 0; c < 16; ++c) { const float br = P.in[11][gid * 16 + c], bi = P.in[12][gid * 16 + c]; S5B[(size_t)gid * 32 + c] = cre * br - cim * bi; S5B[(size_t)gid * 32 + 16 + c] = cre * bi + cim * br; }
        }
    }
    grid.sync(); REIDS();
    { pg8::Gemm gm{XN, W1GU, MTOK, 2 * DFF, DM, DM}; pg8::StaticOrder S; S.init(MTOK, 2 * DFF, G, (int)blockIdx.x); EpiSwiGLU E{ACT, DFF}; pg8::gemm_phase<true>(lds, gm, S, E); }
    xcd_barrier(xbar); REIDS();
    { pg8::Gemm gm{ACT, W1D, MTOK, DM, DFF, DFF}; pg8::StaticOrder S; S.init(MTOK, DM, G, (int)blockIdx.x); EpiStore E{FB, DM}; pg8::gemm_phase<true>(lds, gm, S, E); }
    xcd_barrier(xbar); REIDS();
    for (int m = gw; m < MTOK; m += NGW) rowwise_row(FB + (size_t)m * DM, x + (size_t)m * DM, 0.5f, P.in[5], out + (size_t)m * DM, P.in[6], XN + (size_t)m * DM, lane);
    if (gw < 512) { const int n = gw & 255; const bf16_t* wrow = (gw >> 8 ? CVW1 : CKW1) + (size_t)n * 2048; float s = 0.f;
#pragma unroll
        for (int j = 0; j < 4; ++j) { const int c = 512 * j + 8 * lane; f32x4 w0, w1; unpack8(*(const u32x4*)(wrow + c), w0, w1); const f32x4 p0 = *(const f32x4*)(P.in[18] + c), p1 = *(const f32x4*)(P.in[18] + c + 4);
#pragma unroll
            for (int i = 0; i < 4; ++i) s += w0[i] * p0[i] + w1[i] * p1[i]; }
        s = wave_sum(s); if (lane == 0) CB[gw] = s; }
#if PROGRAM_END > 3
    xcd_barrier(xbar); REIDS();
    { pg8::Gemm gm{XN, WIN, MTOK, NIN, DM, DM}; pg8::StaticOrder S; S.init(MTOK, NIN, G, (int)blockIdx.x); EpiIn E{USSM, QB, KV, GA, GB, GN}; pg8::gemm_phase<false>(lds, gm, S, E); }
    xcd_barrier(xbar); REIDS();
    { pg8::Gemm gm{KV, CKW1, 8192, 256, 2048, 1024}; pg8::StaticOrder S; S.init(8192, 256, G, (int)blockIdx.x); EpiCmp E{H1K, CB}; pg8::gemm_phase<false>(lds, gm, S, E); }
    { pg8::Gemm gm{KV + (size_t)MTOK * 256, CVW1, 8192, 256, 2048, 1024}; pg8::StaticOrder S; S.init(8192, 256, G, (int)((blockIdx.x + G - 32) % G)); EpiCmp E{H1V, CB + 256}; pg8::gemm_phase<false>(lds, gm, S, E); }
    s5_phase(lds, USSM, S5A, S5B, P.in[13], P.in[14], P.in[15], YSSM, tid, lane, wave);
    xcd_barrier(xbar); REIDS();
    cmp2_phase(lds, H1K, H1V, P.in[20], P.in[22], KCMP, VCMPT, tid);
    xcd_barrier(xbar); REIDS();
    nsa_phase(lds, QB, KV, KCMP, VCMPT, GN, P.in[31], ONSA, tid, lane, wave);
    xcd_barrier(xbar); REIDS();
    { pg8::Gemm gm{YSSM, WGLU, MTOK, 4096, 1024, 1024}; pg8::StaticOrder S; S.init(MTOK, 4096, G, (int)blockIdx.x); EpiGLU E{MERGED, GA}; pg8::gemm_phase<true>(lds, gm, S, E); }
    xcd_barrier(xbar); REIDS();
    { pg8::Gemm gm{ONSA, WO, MTOK, 2048, 1024, 1024}; pg8::StaticOrder S; S.init(MTOK, 2048, G, (int)blockIdx.x); EpiWo E{MERGED, GB}; pg8::gemm_phase<true>(lds, gm, S, E); }
    xcd_barrier(xbar); REIDS();
    { pg8::Gemm gm{MERGED, WOUT, MTOK, 2048, 2048, 2048}; pg8::StaticOrder S; S.init(MTOK, 2048, G, (int)blockIdx.x); EpiStore E{MIXED, DM}; pg8::gemm_phase<true>(lds, gm, S, E); }
    xcd_barrier(xbar); REIDS();
    for (int m = gw; m < MTOK; m += NGW) rowwise_row(MIXED + (size_t)m * DM, out + (size_t)m * DM, 1.0f, P.in[25], out + (size_t)m * DM, P.in[26], XN + (size_t)m * DM, lane);
#endif
#if PROGRAM_END > 11
    xcd_barrier(xbar); REIDS();
    { pg8::Gemm gm{XN, W2GU, MTOK, 2 * DFF, DM, DM}; pg8::StaticOrder S; S.init(MTOK, 2 * DFF, G, (int)blockIdx.x); EpiSwiGLU E{ACT, DFF}; pg8::gemm_phase<true>(lds, gm, S, E); }
    xcd_barrier(xbar); REIDS();
    { pg8::Gemm gm{ACT, W2D, MTOK, DM, DFF, DFF}; pg8::StaticOrder S; S.init(MTOK, DM, G, (int)blockIdx.x); EpiStore E{FB, DM}; pg8::gemm_phase<true>(lds, gm, S, E); }
    xcd_barrier(xbar); REIDS();
    for (int m = gw; m < MTOK; m += NGW) rowwise_row(FB + (size_t)m * DM, out + (size_t)m * DM, 0.5f, P.in[30], out + (size_t)m * DM, nullptr, nullptr, lane);
#endif
}

extern "C" void kernel_launch(void* const* d_in, const int* in_sizes, int n_in, void* d_out, int out_size, void* d_ws, size_t ws_size, hipStream_t stream) {
    static int grid_blocks = 0;
    if (!grid_blocks) {
        int dev = 0, cus = 0, per_cu = 0;
        hipGetDevice(&dev);
        hipDeviceGetAttribute(&cus, hipDeviceAttributeMultiprocessorCount, dev);
        hipFuncSetAttribute((const void*)fwd_kernel, hipFuncAttributeMaxDynamicSharedMemorySize, LDS_BYTES);
        hipOccupancyMaxActiveBlocksPerMultiprocessor(&per_cu, (const void*)fwd_kernel, NTHREADS, LDS_BYTES);
        if (per_cu < 1) per_cu = 1;
        grid_blocks = cus * per_cu; if (grid_blocks > 256) grid_blocks = 256;
        if (ws_size < WS_END || n_in != 32) fprintf(stderr, "kernel_launch: unexpected ws_size %zu (need %zu) or n_in %d\n", ws_size, (size_t)WS_END, n_in);
    }
    hipMemsetAsync((char*)d_ws + WS_BAR, 0, 3456 * 4, stream);
    Params p{};
    for (int i = 0; i < 32; ++i) p.in[i] = (const float*)d_in[i];
    p.out = (float*)d_out; p.ws = (unsigned char*)d_ws;
    void* args[] = {&p};
    hipError_t e = hipLaunchCooperativeKernel((const void*)fwd_kernel, dim3(grid_blocks), dim3(NTHREADS), args, LDS_BYTES, stream);
    if (e != hipSuccess) fprintf(stderr, "cooperative launch failed: %s (grid %d)\n", hipGetErrorString(e), grid_blocks);
}
```

```cpp
#include <hip/hip_runtime.h>
#include <hip/hip_cooperative_groups.h>
#include <cstdio>
#include <cstdint>
namespace cg = cooperative_groups;

#define LAS __attribute__((address_space(3)))
typedef unsigned short bf16_t;
typedef short bf16x8 __attribute__((ext_vector_type(8)));
typedef float f32x4 __attribute__((ext_vector_type(4)));
typedef unsigned u32x4 __attribute__((ext_vector_type(4)));
typedef unsigned u32x2 __attribute__((ext_vector_type(2)));

#ifndef PROGRAM_END
#define PROGRAM_END 99
#endif

constexpr int MTOK = 32768, DM = 2048, DFF = 5632, SEQ = 8192;
constexpr int NIN = 7936;
constexpr int LDS_BYTES = 147456;
constexpr int NTHREADS = 512;
constexpr float EPS = 1e-6f;

constexpr size_t SZ_WGU = (size_t)2 * DFF * DM * 2, SZ_WD = (size_t)DM * DFF * 2;
constexpr size_t WS_W1GU = 0;
constexpr size_t WS_W1D = WS_W1GU + SZ_WGU;
constexpr size_t WS_W2GU = WS_W1D + SZ_WD;
constexpr size_t WS_W2D = WS_W2GU + SZ_WGU;
constexpr size_t WS_WIN = WS_W2D + SZ_WD;
constexpr size_t WS_WGLU = WS_WIN + (size_t)NIN * DM * 2;
constexpr size_t WS_WO = WS_WGLU + (size_t)4096 * 1024 * 2;
constexpr size_t WS_WOUT = WS_WO + (size_t)2048 * 1024 * 2;
constexpr size_t WS_CKW1 = WS_WOUT + (size_t)2048 * 2048 * 2;
constexpr size_t WS_CVW1 = WS_CKW1 + (size_t)256 * 2048 * 2;
constexpr size_t WS_XN = WS_CVW1 + (size_t)256 * 2048 * 2;
constexpr size_t WS_ACT = WS_XN + (size_t)MTOK * DM * 2;
constexpr size_t WS_F = WS_ACT + (size_t)MTOK * DFF * 2;
constexpr size_t WS_KV = WS_F + (size_t)MTOK * DM * 2;
constexpr size_t SZ_KV1 = (size_t)MTOK * 256 * 2;
constexpr size_t WS_H1K = WS_KV + 6 * SZ_KV1 + 65536;
constexpr size_t WS_H1V = WS_H1K + (size_t)8192 * 256 * 2;
constexpr size_t WS_KCMP = WS_H1V + (size_t)8192 * 256 * 2;
constexpr size_t WS_VCMPT = WS_KCMP + (size_t)16 * 512 * 64 * 2;
constexpr size_t WS_GN = WS_VCMPT + (size_t)16 * 512 * 64 * 2;
constexpr size_t WS_S5A = WS_GN + (size_t)MTOK * 48 * 4;
constexpr size_t WS_S5B = WS_S5A + (size_t)64 * 64 * 2 * 4;
constexpr size_t WS_CB = WS_S5B + (size_t)64 * 64 * 32 * 4;
constexpr size_t WS_BAR = WS_CB + 2 * 256 * 4;
constexpr size_t WS_END = WS_BAR + 3456 * 4;

__device__ __forceinline__ unsigned f2bf(float f) { unsigned u = __builtin_bit_cast(unsigned, f); return (u + 0x7fffu + ((u >> 16) & 1u)) >> 16; }
__device__ __forceinline__ unsigned pk2(float lo, float hi) { unsigned r; asm volatile("v_cvt_pk_bf16_f32 %0, %1, %2" : "=v"(r) : "v"(lo), "v"(hi)); return r; }
__device__ __forceinline__ float bflo(unsigned u) { return __builtin_bit_cast(float, u << 16); }
__device__ __forceinline__ float bfhi(unsigned u) { return __builtin_bit_cast(float, u & 0xffff0000u); }
__device__ __forceinline__ float fexp(float x) { return __builtin_amdgcn_exp2f(x * 1.44269504089f); }
__device__ __forceinline__ float sigm(float x) { return __builtin_amdgcn_rcpf(1.f + fexp(-x)); }
__device__ __forceinline__ float silu(float x) { return x * sigm(x); }
__device__ __forceinline__ float gelu_tanh(float x) { return x * sigm(1.5957691216f * (x + 0.044715f * x * x * x)); }
__device__ __forceinline__ float wave_sum(float v) {
#pragma unroll
    for (int o = 1; o < 64; o <<= 1) v += __shfl_xor(v, o);
    return v;
}
#define LDS_WAIT() asm volatile("s_waitcnt lgkmcnt(0)" ::: "memory")
#define CBAR() asm volatile("" ::: "memory")
#define MFMA16(a, b, c) __builtin_amdgcn_mfma_f32_16x16x32_bf16(a, b, c, 0, 0, 0)
__device__ __forceinline__ bf16_t tobf(float x) { return (bf16_t)pk2(x, 0.f); }

namespace pg8 {
constexpr int BM = 256, BK = 64, HALF = 128, HTB = HALF * BK * 2, STAGE_BYTES = 8 * HTB, NXCD = 8, WGM = 8;
__host__ __device__ __forceinline__ int lds_byte(int r, int c) { const int st = (r >> 4) * 2 + (c >> 5), rr = r & 15, cc = c & 31, ob = rr * 64 + cc * 2; return st * 1024 + (ob ^ (((ob >> 9) & 1) << 5)); }
__host__ __device__ __forceinline__ void stage_rc(int b, int& R, int& C) { const int st = b / 1024, sb = b % 1024, swz = sb ^ (((sb >> 9) & 1) << 5); R = (st >> 1) * 16 + swz / 64; C = (st & 1) * 32 + (swz % 64) / 2; }
__host__ __device__ __forceinline__ int perm32(int rho) { const int n = rho >> 4, i = rho & 15; return 8 * (i >> 2) + 4 * n + (i & 3); }

struct Unit { int pm, pn; };
struct Gemm { const bf16_t* A; const bf16_t* Bt; int M, N, K, lda; };

struct StaticOrder {
    int nM, nN, nwg, G, c;
    __device__ void init(int M, int N, int G_, int c_) { nM = M / BM; nN = N / BM; nwg = nM * nN; G = G_; c = c_; }
    __device__ bool next(int i, Unit& u) const {
        const long L = (long)i * G + c; if (L >= nwg) return false;
        int wgid = (int)L; { const int q = nwg / NXCD, r = nwg % NXCD, xcd = wgid % NXCD, off = wgid / NXCD; wgid = (xcd < r ? xcd * (q + 1) : r * (q + 1) + (xcd - r) * q) + off; }
        const int nig = WGM * nN, gid = wgid / nig, fm = gid * WGM, gsz = (nM - fm) < WGM ? (nM - fm) : WGM;
        u.pm = fm + ((wgid % nig) % gsz); u.pn = (wgid % nig) / gsz; return true;
    }
};

template <bool LT, class Epi>
__device__ __forceinline__ void gemm_phase(LAS unsigned char* lds, const Gemm g, const StaticOrder& S, const Epi& E) {
    const int tid = LT ? ((const LAS int*)(lds + 145408))[threadIdx.x] : (int)threadIdx.x;
    const int wid = __builtin_amdgcn_readfirstlane(tid >> 6), lane = tid & 63, wr = wid >> 2, wc = wid & 3, fr = lane & 15, fq = lane >> 4;
    const int K = g.K, nt = K / BK, lda = g.lda;
    unsigned voffA[2], voffB[2];
#pragma unroll
    for (int i = 0; i < 2; ++i) { int R, C; stage_rc(tid * 16 + i * 8192, R, C); const int Rb = Epi::PERM ? ((R & ~31) + perm32(R & 31)) : R;
        voffA[i] = (unsigned)(R * lda + C) * 2u; voffB[i] = (unsigned)(Rb * K + C) * 2u; }
    const size_t kstep = (size_t)(BK * 2);
    const size_t hstepA = (size_t)HALF * lda * 2, hstepB = (size_t)HALF * K * 2;
    const size_t tstepA = 2 * hstepA, tstepB = 2 * hstepB;
    const unsigned ldsw = (unsigned)wid * 1024u;
    const int aoff = lds_byte(wr * 64 + fr, fq * 8), boff = lds_byte(wc * 32 + fr, fq * 8);
#define PG8_SA(b, h) (((b) * 2 + (h)) * HTB)
#define PG8_SB(b, h) ((4 + (b) * 2 + (h)) * HTB)
#define PG8_STAGE(bufoff, gbase, voff) do { _Pragma("unroll") for (int _i = 0; _i < 2; ++_i) \
        __builtin_amdgcn_global_load_lds((const unsigned*)((const char*)(gbase) + (voff)[_i]), (LAS unsigned*)(lds + (bufoff) + ldsw + _i * 8192), 16, 0, 0); } while (0)
#define PG8_LDA(dst, b, h) do { _Pragma("unroll") for (int m = 0; m < 4; ++m) _Pragma("unroll") for (int k = 0; k < 2; ++k) dst[m][k] = *(const LAS bf16x8*)(lds + PG8_SA(b, h) + aoff + m * 2048 + k * 1024); } while (0)
#define PG8_LDB(dst, b, h) do { _Pragma("unroll") for (int n = 0; n < 2; ++n) _Pragma("unroll") for (int k = 0; k < 2; ++k) dst[n][k] = *(const LAS bf16x8*)(lds + PG8_SB(b, h) + boff + n * 2048 + k * 1024); } while (0)
#define PG8_MMA(ai, bj, At, Bt) do { __builtin_amdgcn_s_setprio(1); _Pragma("unroll") for (int m = 0; m < 4; ++m) _Pragma("unroll") for (int n = 0; n < 2; ++n) _Pragma("unroll") for (int k = 0; k < 2; ++k) \
        acc[ai][bj][m][n] = __builtin_amdgcn_mfma_f32_16x16x32_bf16(Bt[n][k], At[m][k], acc[ai][bj][m][n], 0, 0, 0); __builtin_amdgcn_s_setprio(0); } while (0)
#define PG8_WAIT_V(n) asm volatile("s_waitcnt vmcnt(" #n ")" ::: "memory")
#define PG8_WAIT_L(n) asm volatile("s_waitcnt lgkmcnt(" #n ")" ::: "memory")
#define PG8_BAR __builtin_amdgcn_s_barrier()
#define PG8_SCHED __builtin_amdgcn_sched_barrier(0)
    Unit cur, nxt; int ui = 0;
    if (!S.next(0, cur)) return;
    f32x4 acc[2][2][4][2];
#pragma unroll
    for (int a = 0; a < 2; ++a)
#pragma unroll
        for (int b = 0; b < 2; ++b)
#pragma unroll
            for (int m = 0; m < 4; ++m)
#pragma unroll
                for (int n = 0; n < 2; ++n) acc[a][b][m][n] = (f32x4){0.f, 0.f, 0.f, 0.f};
    bf16x8 At[4][2], B0[2][2], B1[2][2];
    const char* cA = (const char*)g.A + (size_t)cur.pm * tstepA; const char* cB = (const char*)g.Bt + (size_t)cur.pn * tstepB;
    PG8_STAGE(PG8_SB(0, 0), cB, voffB); PG8_STAGE(PG8_SB(0, 1), cB + hstepB, voffB); PG8_STAGE(PG8_SA(0, 0), cA, voffA); PG8_STAGE(PG8_SA(0, 1), cA + hstepA, voffA);
    if (wr == 1) PG8_BAR;
    PG8_WAIT_V(2); PG8_BAR;
    PG8_STAGE(PG8_SB(1, 0), cB + kstep, voffB); PG8_STAGE(PG8_SA(1, 0), cA + kstep, voffA); PG8_STAGE(PG8_SB(1, 1), cB + hstepB + kstep, voffB);
    PG8_WAIT_V(6); PG8_BAR;
    for (;;) {
        const bool has_next = S.next(ui + 1, nxt);
        const char* nA = has_next ? (const char*)g.A + (size_t)nxt.pm * tstepA : cA; const char* nB = has_next ? (const char*)g.Bt + (size_t)nxt.pn * tstepB : cB;
        for (int t = 0; t < nt; t += 2) {
            const bool last = (t == nt - 2);
            const char* a1 = cA + (size_t)(t + 1) * kstep;
            const char* a2 = last ? nA : cA + (size_t)(t + 2) * kstep; const char* b2 = last ? nB : cB + (size_t)(t + 2) * kstep;
            const char* a3 = a2 + kstep; const char* b3 = b2 + kstep;
            PG8_LDB(B0, 0, 0); PG8_LDB(B1, 0, 1); PG8_SCHED; PG8_LDA(At, 0, 0); PG8_STAGE(PG8_SA(1, 1), a1 + hstepA, voffA);
            PG8_WAIT_V(8); PG8_WAIT_L(0); PG8_BAR; PG8_MMA(0, 0, At, B0); PG8_MMA(0, 1, At, B1); PG8_BAR; PG8_SCHED;
            PG8_LDA(At, 0, 1); PG8_STAGE(PG8_SB(0, 0), b2, voffB); PG8_STAGE(PG8_SB(0, 1), b2 + hstepB, voffB); PG8_STAGE(PG8_SA(0, 0), a2, voffA);
            PG8_WAIT_V(8); PG8_WAIT_L(0); PG8_BAR; PG8_MMA(1, 0, At, B0); PG8_MMA(1, 1, At, B1); PG8_BAR; PG8_SCHED;
            PG8_LDB(B0, 1, 0); PG8_LDB(B1, 1, 1); PG8_SCHED; PG8_LDA(At, 1, 0); PG8_STAGE(PG8_SA(0, 1), a2 + hstepA, voffA);
            PG8_WAIT_V(8); PG8_WAIT_L(0); PG8_BAR; PG8_MMA(0, 0, At, B0); PG8_MMA(0, 1, At, B1); PG8_BAR; PG8_SCHED;
            PG8_LDA(At, 1, 1); PG8_STAGE(PG8_SB(1, 0), b3, voffB); PG8_STAGE(PG8_SB(1, 1), b3 + hstepB, voffB); PG8_STAGE(PG8_SA(1, 0), a3, voffA);
            PG8_WAIT_V(8); PG8_WAIT_L(0); PG8_BAR; PG8_MMA(1, 0, At, B0); PG8_MMA(1, 1, At, B1); PG8_BAR; PG8_SCHED;
        }
        if (wr == 0) PG8_BAR;
        E(acc, cur, wr, wc, fr, fq);
        if (!has_next) break;
#pragma unroll
        for (int a = 0; a < 2; ++a)
#pragma unroll
            for (int b = 0; b < 2; ++b)
#pragma unroll
                for (int m = 0; m < 4; ++m)
#pragma unroll
                    for (int n = 0; n < 2; ++n) acc[a][b][m][n] = (f32x4){0.f, 0.f, 0.f, 0.f};
        cur = nxt; cA = nA; cB = nB; ++ui;
        if (wr == 1) PG8_BAR;
    }
    PG8_WAIT_V(0);
    PG8_BAR;
#undef PG8_SA
#undef PG8_SB
#undef PG8_STAGE
#undef PG8_LDA
#undef PG8_LDB
#undef PG8_MMA
#undef PG8_WAIT_V
#undef PG8_WAIT_L
#undef PG8_BAR
#undef PG8_SCHED
}
}
using pg8::Unit;
typedef const f32x4 (&AccRef)[2][2][4][2];

__device__ __forceinline__ u32x4 pack8(f32x4 a, f32x4 b) { u32x4 o; o.x = pk2(a[0], a[1]); o.y = pk2(a[2], a[3]); o.z = pk2(b[0], b[1]); o.w = pk2(b[2], b[3]); return o; }
__device__ __forceinline__ void unpack8(u32x4 v, f32x4& a, f32x4& b) { a[0] = bflo(v.x); a[1] = bfhi(v.x); a[2] = bflo(v.y); a[3] = bfhi(v.y); b[0] = bflo(v.z); b[1] = bfhi(v.z); b[2] = bflo(v.w); b[3] = bfhi(v.w); }

struct EpiStore {
    static constexpr bool PERM = true; bf16_t* O; int ldc;
    __device__ __forceinline__ void operator()(AccRef acc, const Unit& u, int wr, int wc, int fr, int fq) const {
        const int row0 = u.pm * 256 + wr * 64 + fr, col0 = u.pn * 256 + wc * 32 + 8 * fq;
#pragma unroll
        for (int ai = 0; ai < 2; ++ai)
#pragma unroll
            for (int m = 0; m < 4; ++m) { bf16_t* rowp = O + (size_t)(row0 + ai * 128 + m * 16) * ldc + col0;
#pragma unroll
                for (int bj = 0; bj < 2; ++bj) *(u32x4*)(rowp + bj * 128) = pack8(acc[ai][bj][m][0], acc[ai][bj][m][1]); }
    }
};
struct EpiSwiGLU {
    static constexpr bool PERM = true; bf16_t* O; int ldc;
    __device__ __forceinline__ void operator()(AccRef acc, const Unit& u, int wr, int wc, int fr, int fq) const {
        const int row0 = u.pm * 256 + wr * 64 + fr, col0 = u.pn * 128 + wc * 32 + 8 * fq;
#pragma unroll
        for (int ai = 0; ai < 2; ++ai)
#pragma unroll
            for (int m = 0; m < 4; ++m) { bf16_t* rowp = O + (size_t)(row0 + ai * 128 + m * 16) * ldc + col0;
                f32x4 a, b;
#pragma unroll
                for (int i = 0; i < 4; ++i) { a[i] = silu(acc[ai][0][m][0][i]) * acc[ai][1][m][0][i]; b[i] = silu(acc[ai][0][m][1][i]) * acc[ai][1][m][1][i]; }
                *(u32x4*)rowp = pack8(a, b); }
    }
};
struct EpiGLU {
    static constexpr bool PERM = true; bf16_t* O; const bf16_t* GA;
    __device__ __forceinline__ void operator()(AccRef acc, const Unit& u, int wr, int wc, int fr, int fq) const {
        const int row0 = u.pm * 256 + wr * 64 + fr, col0 = u.pn * 128 + wc * 32 + 8 * fq;
#pragma unroll
        for (int ai = 0; ai < 2; ++ai)
#pragma unroll
            for (int m = 0; m < 4; ++m) { const size_t off = (size_t)(row0 + ai * 128 + m * 16) * 2048 + col0;
                f32x4 g0, g1, a, b; unpack8(*(const u32x4*)(GA + off), g0, g1);
#pragma unroll
                for (int i = 0; i < 4; ++i) { a[i] = g0[i] * acc[ai][0][m][0][i] * sigm(acc[ai][1][m][0][i]); b[i] = g1[i] * acc[ai][0][m][1][i] * sigm(acc[ai][1][m][1][i]); }
                *(u32x4*)(O + off) = pack8(a, b); }
    }
};
struct EpiWo {
    static constexpr bool PERM = true; bf16_t* O; const bf16_t* GB;
    __device__ __forceinline__ void operator()(AccRef acc, const Unit& u, int wr, int wc, int fr, int fq) const {
        const int row0 = u.pm * 256 + wr * 64 + fr, col0 = u.pn * 256 + wc * 32 + 8 * fq;
#pragma unroll
        for (int ai = 0; ai < 2; ++ai)
#pragma unroll
            for (int m = 0; m < 4; ++m)
#pragma unroll
                for (int bj = 0; bj < 2; ++bj) { const size_t off = (size_t)(row0 + ai * 128 + m * 16) * 2048 + col0 + bj * 128;
                    f32x4 g0, g1, o0, o1, a, b; unpack8(*(const u32x4*)(GB + off), g0, g1); unpack8(*(const u32x4*)(O + off), o0, o1);
#pragma unroll
                    for (int i = 0; i < 4; ++i) { a[i] = o0[i] + g0[i] * acc[ai][bj][m][0][i]; b[i] = o1[i] + g1[i] * acc[ai][bj][m][1][i]; }
                    *(u32x4*)(O + off) = pack8(a, b); }
    }
};
struct EpiCmp {
    static constexpr bool PERM = true; bf16_t* O; const float* bias;
    __device__ __forceinline__ void operator()(AccRef acc, const Unit& u, int wr, int wc, int fr, int fq) const {
        const int row0 = u.pm * 256 + wr * 64 + fr, col0 = wc * 32 + 8 * fq;
#pragma unroll
        for (int bj = 0; bj < 2; ++bj) { const f32x4 b0 = *(const f32x4*)(bias + col0 + bj * 128), b1 = *(const f32x4*)(bias + col0 + bj * 128 + 4);
#pragma unroll
            for (int ai = 0; ai < 2; ++ai)
#pragma unroll
                for (int m = 0; m < 4; ++m) { f32x4 a, b;
#pragma unroll
                    for (int i = 0; i < 4; ++i) { a[i] = gelu_tanh(acc[ai][bj][m][0][i] + b0[i]); b[i] = gelu_tanh(acc[ai][bj][m][1][i] + b1[i]); }
                    *(u32x4*)(O + (size_t)(row0 + ai * 128 + m * 16) * 256 + col0 + bj * 128) = pack8(a, b); } }
    }
};
struct EpiIn {
    static constexpr bool PERM = true;
    bf16_t *USSM, *Q, *KV, *GA, *GB; float* GN;
    __device__ __forceinline__ void operator()(AccRef acc, const Unit& u, int wr, int wc, int fr, int fq) const {
        const int row0 = u.pm * 256 + wr * 64 + fr, cw = wc * 32 + 8 * fq; const int pn = u.pn;
        if (pn < 8) {
            bf16_t* base = pn < 4 ? USSM : Q; const float sc = pn < 4 ? 1.f : 0.18033688f  ; const int col0 = (pn & 3) * 256 + cw;
#pragma unroll
            for (int ai = 0; ai < 2; ++ai)
#pragma unroll
                for (int m = 0; m < 4; ++m) { bf16_t* rowp = base + (size_t)(row0 + ai * 128 + m * 16) * 1024 + col0;
#pragma unroll
                    for (int bj = 0; bj < 2; ++bj) *(u32x4*)(rowp + bj * 128) = pack8(acc[ai][bj][m][0] * sc, acc[ai][bj][m][1] * sc); }
        } else if (pn < 14) {
            const int kind = pn - 8; bf16_t* base = KV + (size_t)kind * ((size_t)MTOK * 256);
            const bool tr = (kind == 3) || (kind == 5);
#pragma unroll
            for (int ai = 0; ai < 2; ++ai)
#pragma unroll
                for (int m = 0; m < 4; ++m) { const int row = row0 + ai * 128 + m * 16, b = row >> 13, t = row & 8191;
#pragma unroll
                    for (int bj = 0; bj < 2; ++bj) { const int c = bj * 128 + cw, gg = c >> 6, d = c & 63;
                        if (!tr) *(u32x4*)(base + ((size_t)((b * 4 + gg) * SEQ + t)) * 64 + d) = pack8(acc[ai][bj][m][0], acc[ai][bj][m][1]);
                        else { bf16_t* p = base + ((size_t)((b * 4 + gg) * 64 + d)) * SEQ + t;
#pragma unroll
                            for (int i = 0; i < 4; ++i) { p[(size_t)i * SEQ] = (bf16_t)f2bf(acc[ai][bj][m][0][i]); p[(size_t)(4 + i) * SEQ] = (bf16_t)f2bf(acc[ai][bj][m][1][i]); } } } }
        } else if (pn < 30) {
            bf16_t* base = pn < 22 ? GA : GB; const int col0 = ((pn - 14) & 7) * 256 + cw;
#pragma unroll
            for (int ai = 0; ai < 2; ++ai)
#pragma unroll
                for (int m = 0; m < 4; ++m) { bf16_t* rowp = base + (size_t)(row0 + ai * 128 + m * 16) * 2048 + col0;
#pragma unroll
                    for (int bj = 0; bj < 2; ++bj) { f32x4 a, b;
#pragma unroll
                        for (int i = 0; i < 4; ++i) { a[i] = sigm(acc[ai][bj][m][0][i]); b[i] = sigm(acc[ai][bj][m][1][i]); }
                        *(u32x4*)(rowp + bj * 128) = pack8(a, b); } }
        } else {
            if (cw < 48) {
#pragma unroll
                for (int ai = 0; ai < 2; ++ai)
#pragma unroll
                    for (int m = 0; m < 4; ++m) { float* rowp = GN + (size_t)(row0 + ai * 128 + m * 16) * 48 + cw; f32x4 a, b;
#pragma unroll
                        for (int i = 0; i < 4; ++i) { a[i] = sigm(acc[ai][0][m][0][i]); b[i] = sigm(acc[ai][0][m][1][i]); }
                        *(f32x4*)rowp = a; *(f32x4*)(rowp + 4) = b; }
            }
        }
    }
};

__device__ __forceinline__ void tr_item(const float* __restrict__ W, int ldw, bf16_t* WT, int K, int k0, int src_col0, int nvalid, int dest_row0, LAS float* scr, int lane) {
    const int c = lane & 31;
    float wv[32];
#pragma unroll
    for (int i = 0; i < 32; ++i) { const int kk = 2 * i + (lane >> 5); wv[i] = (c < nvalid) ? W[(size_t)(k0 + kk) * ldw + src_col0 + c] : 0.f; }
#pragma unroll
    for (int i = 0; i < 32; ++i) { const int kk = 2 * i + (lane >> 5); scr[kk * 33 + c] = wv[i]; }
    LDS_WAIT();
    const int c8 = lane & 7;
#pragma unroll
    for (int j = 0; j < 4; ++j) { const int n = (lane >> 3) + 8 * j; const LAS float* s = scr + (8 * c8) * 33 + n;
        u32x4 o; o.x = pk2(s[0 * 33], s[1 * 33]); o.y = pk2(s[2 * 33], s[3 * 33]); o.z = pk2(s[4 * 33], s[5 * 33]); o.w = pk2(s[6 * 33], s[7 * 33]);
        *(u32x4*)(WT + (size_t)(dest_row0 + n) * K + k0 + 8 * c8) = o; }
    LDS_WAIT();
}
__device__ __forceinline__ void tr_job(const float* W, int ldw, int K, int nblk, bf16_t* WT, int item, int mode, LAS float* scr, int lane) {
    const int kb = item / nblk, nb = item - kb * nblk; int src = 32 * nb, dst = 32 * nb, nv = 32;
    if (mode == 1 || mode == 2) dst = (src >> 7) * 256 + (mode - 1) * 128 + (src & 127);
    else if (mode == 3) { if (dst < 3584) src = dst; else if (dst < 7680) src = dst + 48; else if (dst < 7712) src = 3584; else if (dst < 7744) { src = 3616; nv = 16; } else { src = 0; nv = 0; } }
    tr_item(W, ldw, WT, K, 64 * kb, src, nv, dst, scr, lane);
}

__device__ __forceinline__ void rowwise_row(const bf16_t* frow, const float* hin, float coef, const float* gpost, float* hout, const float* gpre, bf16_t* xn, int lane) {
    f32x4 f[4][2], h[4][2]; float ss = 0.f;
#pragma unroll
    for (int j = 0; j < 4; ++j) { unpack8(*(const u32x4*)(frow + 512 * j + 8 * lane), f[j][0], f[j][1]);
#pragma unroll
        for (int i = 0; i < 4; ++i) ss += f[j][0][i] * f[j][0][i] + f[j][1][i] * f[j][1][i]; }
    const float rs = coef * __frsqrt_rn(wave_sum(ss) * (1.f / DM) + EPS); float s2 = 0.f;
#pragma unroll
    for (int j = 0; j < 4; ++j)
#pragma unroll
        for (int q = 0; q < 2; ++q) { const int c = 512 * j + 8 * lane + 4 * q; const f32x4 hv = (hin != hout) ? __builtin_nontemporal_load((const f32x4*)(hin + c)) : *(const f32x4*)(hin + c), gp = *(const f32x4*)(gpost + c);
            h[j][q] = hv + f[j][q] * rs * gp; *(f32x4*)(hout + c) = h[j][q];
#pragma unroll
            for (int i = 0; i < 4; ++i) s2 += h[j][q][i] * h[j][q][i]; }
    if (xn) { const float r2 = __frsqrt_rn(wave_sum(s2) * (1.f / DM) + EPS);
#pragma unroll
        for (int j = 0; j < 4; ++j) { const int c = 512 * j + 8 * lane; const f32x4 g0 = *(const f32x4*)(gpre + c), g1 = *(const f32x4*)(gpre + c + 4);
            *(u32x4*)(xn + c) = pack8(h[j][0] * r2 * g0, h[j][1] * r2 * g1); } }
}
__device__ __forceinline__ void norm_row(const float* xrow, const float* g, bf16_t* xn, int lane) {
    f32x4 h[4][2]; float s2 = 0.f;
#pragma unroll
    for (int j = 0; j < 4; ++j)
#pragma unroll
        for (int q = 0; q < 2; ++q) { h[j][q] = *(const f32x4*)(xrow + 512 * j + 8 * lane + 4 * q);
#pragma unroll
            for (int i = 0; i < 4; ++i) s2 += h[j][q][i] * h[j][q][i]; }
    const float r2 = __frsqrt_rn(wave_sum(s2) * (1.f / DM) + EPS);
#pragma unroll
    for (int j = 0; j < 4; ++j) { const int c = 512 * j + 8 * lane; const f32x4 g0 = *(const f32x4*)(g + c), g1 = *(const f32x4*)(g + c + 4);
        *(u32x4*)(xn + c) = pack8(h[j][0] * r2 * g0, h[j][1] * r2 * g1); }
}

struct Params { const float* in[32]; float* out; unsigned char* ws; };


__device__ __forceinline__ bf16x8 pack_bf8(const float* p, float sgn) {
    const f32x4 a = *(const f32x4*)p, b = *(const f32x4*)(p + 4); u32x4 o; o.x = pk2(sgn * a[0], sgn * a[1]); o.y = pk2(sgn * a[2], sgn * a[3]); o.z = pk2(sgn * b[0], sgn * b[1]); o.w = pk2(sgn * b[2], sgn * b[3]);
    return __builtin_bit_cast(bf16x8, o);
}
__device__ __forceinline__ void s5_phase(LAS unsigned char* lds, const bf16_t* USSM, const float* S5A, const float* S5B, const float* c_re, const float* c_im, const float* dskip,
                                         bf16_t* YSSM, int tid, int lane, int wave) {
    LAS float* carry = (LAS float*)lds;
    LAS unsigned char* wb = lds + 4096 + wave * 13312;
    LAS float* BU = (LAS float*)wb;
    LAS bf16_t* XB = (LAS bf16_t*)(wb + 8448);
    LAS bf16_t* UST = (LAS bf16_t*)(wb + 8448 + 4352);
    const int r16 = lane & 15, q4 = lane >> 4;
    const f32x4 z4 = {0.f, 0.f, 0.f, 0.f};
    const bf16x8 zf = {0, 0, 0, 0, 0, 0, 0, 0};
    for (int bg = blockIdx.x; bg < 256; bg += gridDim.x) {
        const int b = bg >> 6, g = bg & 63;
        __syncthreads();
        const float are = S5A[(g * 64 + lane) * 2], aim = S5A[(g * 64 + lane) * 2 + 1];
        bf16x8 bfr[8], cfr[4];
#pragma unroll
        for (int nt = 0; nt < 8; ++nt) { const int pp = nt * 16 + r16, p = pp & 63, im = pp >> 6; bfr[nt] = q4 < 2 ? pack_bf8(S5B + (size_t)(g * 64 + p) * 32 + im * 16 + q4 * 8, 1.f) : zf; }
#pragma unroll
        for (int ks = 0; ks < 4; ++ks) { const int pp = ks * 32 + q4 * 8, p = pp & 63, im = pp >> 6; cfr[ks] = pack_bf8((im ? c_im : c_re) + (size_t)(g * 16 + r16) * 64 + p, im ? -1.f : 1.f); }
        const float dsk = dskip[g * 16 + r16];
        const bf16_t* ub = USSM + ((size_t)(b * SEQ + wave * 1024)) * 1024 + g * 16;
        float xr = 0.f, xi = 0.f;
        for (int tb = 0; tb < 64; ++tb) {
            bf16x8 a = *(const bf16x8*)(ub + (size_t)(tb * 16 + r16) * 1024 + (q4 & 1) * 8); if (q4 >= 2) a = zf;
#pragma unroll
            for (int nt = 0; nt < 8; ++nt) { const f32x4 acc = MFMA16(a, bfr[nt], z4);
#pragma unroll
                for (int i = 0; i < 4; ++i) BU[(q4 * 4 + i) * 132 + nt * 16 + r16] = acc[i]; }
            LDS_WAIT();
#pragma unroll
            for (int t = 0; t < 16; ++t) { const float br = BU[t * 132 + lane], bi = BU[t * 132 + 64 + lane];
                const float nr = are * xr - aim * xi + br, ni = are * xi + aim * xr + bi; xr = nr; xi = ni; }
            LDS_WAIT();
        }
        carry[(wave * 64 + lane) * 2] = xr; carry[(wave * 64 + lane) * 2 + 1] = xi;
        __syncthreads();
        float pr = are, pi = aim;
#pragma unroll
        for (int k = 0; k < 10; ++k) { const float t2 = pr * pr - pi * pi; pi = 2.f * pr * pi; pr = t2; }
        xr = 0.f; xi = 0.f;
        for (int k = 0; k < wave; ++k) { const float er = carry[(k * 64 + lane) * 2], ei = carry[(k * 64 + lane) * 2 + 1]; const float nr = pr * xr - pi * xi + er, ni = pr * xi + pi * xr + ei; xr = nr; xi = ni; }
        for (int tb = 0; tb < 64; ++tb) {
            bf16x8 a = *(const bf16x8*)(ub + (size_t)(tb * 16 + r16) * 1024 + (q4 & 1) * 8); *(LAS bf16x8*)(UST + r16 * 16 + (q4 & 1) * 8) = a; if (q4 >= 2) a = zf;
#pragma unroll
            for (int nt = 0; nt < 8; ++nt) { const f32x4 acc = MFMA16(a, bfr[nt], z4);
#pragma unroll
                for (int i = 0; i < 4; ++i) BU[(q4 * 4 + i) * 132 + nt * 16 + r16] = acc[i]; }
            LDS_WAIT();
#pragma unroll
            for (int t = 0; t < 16; ++t) { const float br = BU[t * 132 + lane], bi = BU[t * 132 + 64 + lane];
                const float nr = are * xr - aim * xi + br, ni = are * xi + aim * xr + bi; xr = nr; xi = ni;
                XB[t * 136 + lane] = tobf(xr); XB[t * 136 + 64 + lane] = tobf(xi); }
            LDS_WAIT();
            f32x4 y = z4;
#pragma unroll
            for (int ks = 0; ks < 4; ++ks) y = MFMA16(*(const LAS bf16x8*)(XB + r16 * 136 + ks * 32 + q4 * 8), cfr[ks], y);
#pragma unroll
            for (int i = 0; i < 4; ++i) { const float u = bflo((unsigned)UST[(q4 * 4 + i) * 16 + r16]); BU[(q4 * 4 + i) * 16 + r16] = gelu_tanh(y[i] + dsk * u); }
            LDS_WAIT();
            { const f32x4 v = *(const LAS f32x4*)(BU + (lane >> 2) * 16 + (lane & 3) * 4); u32x2 o; o.x = pk2(v[0], v[1]); o.y = pk2(v[2], v[3]);
              *(u32x2*)(YSSM + ((size_t)(b * SEQ + wave * 1024 + tb * 16 + (lane >> 2))) * 1024 + g * 16 + (lane & 3) * 4) = o; }
            LDS_WAIT();
        }
    }
    __syncthreads();
}

__device__ __forceinline__ void cmp2_phase(LAS unsigned char* lds, const bf16_t* H1K, const bf16_t* H1V, const float* w2k, const float* w2v, bf16_t* KCMP, bf16_t* VCMPT, int tid) {
    LAS float* w2s = (LAS float*)lds;
    for (int i = tid; i < 32768; i += NTHREADS) w2s[i] = i < 16384 ? w2k[i] : w2v[i - 16384];
    __syncthreads();
    const int d = tid & 63, rsub = tid >> 6;
    for (int rg = blockIdx.x; rg < 1024; rg += gridDim.x) {
        const int row = rg * 8 + rsub; const bf16_t* hk = H1K + (size_t)row * 256; const bf16_t* hv = H1V + (size_t)row * 256;
        float ak = 0.f, av = 0.f;
        for (int n = 0; n < 256; n += 8) { f32x4 k0, k1, v0, v1; unpack8(*(const u32x4*)(hk + n), k0, k1); unpack8(*(const u32x4*)(hv + n), v0, v1);
#pragma unroll
            for (int j = 0; j < 4; ++j) { ak += k0[j] * w2s[(n + j) * 64 + d] + k1[j] * w2s[(n + 4 + j) * 64 + d]; av += v0[j] * w2s[16384 + (n + j) * 64 + d] + v1[j] * w2s[16384 + (n + 4 + j) * 64 + d]; } }
        const int bgi = row >> 9, i = row & 511; const bool ok = i < 511;
        KCMP[(size_t)row * 64 + d] = ok ? (bf16_t)f2bf(ak) : (bf16_t)0;
        VCMPT[((size_t)(bgi * 64 + d)) * 512 + i] = ok ? (bf16_t)f2bf(av) : (bf16_t)0;
    }
    __syncthreads();
}

__device__ __forceinline__ float red16(float v) { v += __shfl_xor(v, 1); v += __shfl_xor(v, 2); v += __shfl_xor(v, 4); v += __shfl_xor(v, 8); return v; }
__device__ __forceinline__ int clampd(int d) { return d < 0 ? 0 : (d > 1024 ? 1024 : d); }

__device__ __forceinline__ float ex2(float x) { return __builtin_amdgcn_exp2f(x); }
struct KFrag { bf16x8 k[4][2]; };
struct VFrag { bf16x8 v[2][4]; };
__device__ __forceinline__ void load_k(KFrag& f, const char* kb, unsigned koffB) {
#pragma unroll
    for (int cc = 0; cc < 4; ++cc) { f.k[cc][0] = *(const bf16x8*)(kb + cc * 2048 + koffB); f.k[cc][1] = *(const bf16x8*)(kb + cc * 2048 + 64 + koffB); }
}
__device__ __forceinline__ void load_v(VFrag& f, const char* vb, unsigned voffB, int vstride) {
#pragma unroll
    for (int ks = 0; ks < 2; ++ks)
#pragma unroll
        for (int nt = 0; nt < 4; ++nt) f.v[ks][nt] = *(const bf16x8*)(vb + (size_t)nt * 32 * vstride + ks * 64 + voffB);
}
__device__ __forceinline__ void pv_step(const VFrag& f, f32x4 (&o)[4], const LAS bf16_t* Pb, int r16, int q4) {
    CBAR();
#pragma unroll
    for (int ks = 0; ks < 2; ++ks) { const bf16x8 aP = *(const LAS bf16x8*)(Pb + r16 * 72 + ks * 32 + q4 * 8);
#pragma unroll
        for (int nt = 0; nt < 4; ++nt) o[nt] = MFMA16(aP, f.v[ks][nt], o[nt]); }
    CBAR();
}
__device__ __forceinline__ void qk_scores(const KFrag& f, const LAS bf16_t* qf, f32x4 (&sc)[4]) {
    const f32x4 z4 = {0.f, 0.f, 0.f, 0.f};
    const bf16x8 aq0 = *(const LAS bf16x8*)qf, aq1 = *(const LAS bf16x8*)(qf + 512);
#pragma unroll
    for (int cc = 0; cc < 4; ++cc) { sc[cc] = MFMA16(aq0, f.k[cc][0], z4); sc[cc] = MFMA16(aq1, f.k[cc][1], sc[cc]); }
}
template <int TT> __device__ __forceinline__ void sel_sm(const f32x4 (&sc)[4], int j, int tok, const LAS float* bt, LAS bf16_t* Pb, float& lsum, int r16, int q4) {
#pragma unroll
    for (int cc = 0; cc < 4; ++cc) {
        const int dist = tok - (64 * j + cc * 16 + r16);
        const float p = dist >= 0 ? ex2(sc[cc][TT] + bt[clampd(dist)]) : 0.f; lsum += p;
        Pb[(4 * q4 + TT) * 72 + cc * 16 + r16] = tobf(p);
    }
}
__device__ __forceinline__ void win_sm(const f32x4 (&sc)[4], int gr, int t0, const LAS float* bt, LAS bf16_t* Pb, float (&lw)[4], int r16, int q4) {
#pragma unroll
    for (int cc = 0; cc < 4; ++cc) {
        const int pos = gr * 64 + cc * 16 + r16;
#pragma unroll
        for (int i = 0; i < 4; ++i) { const int dist = t0 + i - pos; const float p = ((unsigned)dist < 512u) ? ex2(sc[cc][i] + bt[clampd(dist)]) : 0.f; lw[i] += p; Pb[(4 * q4 + i) * 72 + cc * 16 + r16] = tobf(p); }
    }
}
__device__ __forceinline__ void cmp_sm1(const f32x4 (&sc)[4], int gr, int t0, const LAS float* bt, float (&ls)[4], int r16) {
#pragma unroll
    for (int cc = 0; cc < 4; ++cc) {
        const int cend = (gr * 64 + cc * 16 + r16) * 16 + 31;
#pragma unroll
        for (int i = 0; i < 4; ++i) { const int dist = t0 + i - cend; ls[i] += dist >= 0 ? ex2(sc[cc][i] + bt[clampd(dist)]) : 0.f; }
    }
}
__device__ __forceinline__ void cmp_sm2(const f32x4 (&sc)[4], int gr, int t0, const LAS float* bt, const float (&inv)[4], LAS bf16_t* Pb, LAS float* psum, int r16, int q4) {
#pragma unroll
    for (int cc = 0; cc < 4; ++cc) {
        const int kk = gr * 64 + cc * 16 + r16, cend = kk * 16 + 31;
#pragma unroll
        for (int i = 0; i < 4; ++i) { const int dist = t0 + i - cend; float p = dist >= 0 ? ex2(sc[cc][i] + bt[clampd(dist)]) * inv[i] : 0.f;
            Pb[(4 * q4 + i) * 72 + cc * 16 + r16] = tobf(p); p += __shfl_xor(p, 16); p += __shfl_xor(p, 32); if (q4 == 0) psum[i * 512 + kk] = p; }
    }
}

__device__ __forceinline__ void nsa_quad_pre(int bg, int quad, const bf16_t* Q, const bf16_t* KV, const bf16_t* KCMP, const bf16_t* VCMPT, const float* GN, bf16_t* ONSA,
                                             const LAS float* btab, LAS bf16_t* Pb, LAS float* psum, LAS int* selq, LAS bf16_t* qfw, int lane) {
    const int r16 = lane & 15, q4 = lane >> 4, b = bg >> 2, g = bg & 3, t0 = quad * 4;
    const unsigned koff = (unsigned)(r16 * 64 + q4 * 8) * 2u, voffS = (unsigned)(r16 * SEQ + q4 * 8) * 2u, voffC = (unsigned)(r16 * 512 + q4 * 8) * 2u;
    const char* KWb = (const char*)(KV + 4 * (size_t)MTOK * 256 + (size_t)bg * SEQ * 64); const char* VWb = (const char*)(KV + 5 * (size_t)MTOK * 256 + (size_t)bg * 64 * SEQ);
    const char* KCb = (const char*)(KCMP + (size_t)bg * 512 * 64); const char* VCb = (const char*)(VCMPT + (size_t)bg * 64 * 512);
#define KP_C(i) KCb + (i) * 8192, koff
#define VP_C(i) VCb + (i) * 128, voffC, 512
#define KP_W(i) KWb + (i) * 8192, koff
#define VP_W(i) VWb + (i) * 128, voffS, SEQ
    const size_t qoff = (size_t)(b * SEQ + t0 + (r16 & 3)) * 1024 + (g * 4 + (r16 >> 2)) * 64 + q4 * 8;
    { const bf16x8 a0 = *(const bf16x8*)(Q + qoff), a1 = *(const bf16x8*)(Q + qoff + 32); *(LAS bf16x8*)(qfw + lane * 8) = a0; *(LAS bf16x8*)(qfw + 512 + lane * 8) = a1; }
    const LAS bf16_t* qf = qfw + lane * 8;
    const LAS float* bt = btab + q4 * 1028;
    const f32x4 z4 = {0.f, 0.f, 0.f, 0.f};
    KFrag KF; VFrag VF; f32x4 sc[4];
    const int w_lo = (t0 - 511 > 0 ? t0 - 511 : 0) >> 6, w_hi = t0 >> 6;
    f32x4 oc[4] = {z4, z4, z4, z4};
    const int tl = t0 + 3, nvmax = tl >= 31 ? ((tl - 31) >> 4) + 1 : 0, ngr = (nvmax + 63) >> 6;
    if (ngr > 0) {
        float ls[4] = {0.f, 0.f, 0.f, 0.f};
        load_k(KF, KP_C(0));
        for (int gr = 0; gr < ngr; ++gr) {
            qk_scores(KF, qf, sc);
            load_k(KF, KP_C(gr + 1 < ngr ? gr + 1 : 0));
            cmp_sm1(sc, gr, t0, bt, ls, r16);
        }
        load_v(VF, VP_C(0));
        float inv[4];
#pragma unroll
        for (int i = 0; i < 4; ++i) { const float l = red16(ls[i]); inv[i] = l > 0.f ? 1.f / l : 0.f; }
        for (int gr = 0; gr < ngr; ++gr) {
            const bool more = gr + 1 < ngr;
            qk_scores(KF, qf, sc);
            if (more) load_k(KF, KP_C(gr + 1));
            cmp_sm2(sc, gr, t0, bt, inv, Pb, psum, r16, q4);
            pv_step(VF, oc, Pb, r16, q4);
            if (more) load_v(VF, VP_C(gr + 1));
        }
    }
    CBAR();
#pragma unroll
    for (int tt = 0; tt < 4; ++tt) {
        const int tok = t0 + tt, cur = tok >> 6;
        if (cur < 16) { if (lane < 16) selq[tt * 16 + lane] = lane; }
        else {
            unsigned k0 = 0u, k1 = 0u;
            { const int j = lane; if (j >= 1 && j <= cur - 2) { const LAS float* ps = psum + tt * 512 + 4 * j - 1; const float v = ps[0] + ps[1] + ps[2] + ps[3] + ps[4]; k0 = (__builtin_bit_cast(unsigned, v) & ~127u) | (unsigned)(127 - j); } }
            { const int j = lane + 64; if (j <= cur - 2) { const LAS float* ps = psum + tt * 512 + 4 * j - 1; const float v = ps[0] + ps[1] + ps[2] + ps[3] + ps[4]; k1 = (__builtin_bit_cast(unsigned, v) & ~127u) | (unsigned)(127 - j); } }
            for (int it = 0; it < 13; ++it) {
                unsigned m = k0 > k1 ? k0 : k1;
#pragma unroll
                for (int off = 32; off >= 1; off >>= 1) { const unsigned o = (unsigned)__shfl_xor((int)m, off); m = o > m ? o : m; }
                if (k0 == m) k0 = 0u; if (k1 == m) k1 = 0u;
                if (lane == 0) selq[tt * 16 + it] = 127 - (int)(m & 127u);
            }
            if (lane == 0) { selq[tt * 16 + 13] = 0; selq[tt * 16 + 14] = cur - 1; selq[tt * 16 + 15] = cur; }
        }
    }
    CBAR();
#pragma unroll
    for (int tt = 0; tt < 4; ++tt) { const float gc = GN[(size_t)(b * SEQ + t0 + tt) * 48 + (g * 4 + q4) * 3];
        bf16_t* op = ONSA + (size_t)(b * SEQ + t0 + tt) * 1024 + (g * 4 + q4) * 64 + r16;
#pragma unroll
        for (int nt = 0; nt < 4; ++nt) op[nt * 16] = tobf(gc * oc[nt][tt]); }
#undef KP_C
#undef VP_C
#undef KP_W
#undef VP_W
}

template <int MODE>
__device__ __forceinline__ void nsa_block_loop(int bg, int qb, const bf16_t* Q, const bf16_t* KV, const float* GN, bf16_t* ONSA, const LAS float* btab, LAS bf16_t* Pb,
                                               const LAS int* selall, LAS unsigned* masks, LAS bf16_t* stage, int tid, int lane, int wave) {
    const int r16 = lane & 15, q4 = lane >> 4, b = bg >> 2, g = bg & 3;
    const bf16_t* Kt = KV + (MODE ? 4 : 2) * (size_t)MTOK * 256 + (size_t)bg * SEQ * 64; const bf16_t* Vt = KV + (MODE ? 5 : 3) * (size_t)MTOK * 256 + (size_t)bg * 64 * SEQ;
    const LAS float* bt = btab + q4 * 1028;
    const float bfar = bt[1024];
    const f32x4 z4 = {0.f, 0.f, 0.f, 0.f};
    const int j0 = MODE ? (qb - 8 > 0 ? qb - 8 : 0) : 0;
    if (MODE == 0 && tid < 256) { const int tok = tid >> 2, word = tid & 3; unsigned m = 0u;
        if (qb < 16) m = word == 0 ? ((2u << qb) - 1u) : 0u;
        else {
#pragma unroll
            for (int n = 0; n < 16; ++n) { const int j = selall[tok * 16 + n]; m |= ((j >> 5) == word) ? (1u << (j & 31)) : 0u; } }
        masks[tid] = m; }
    bf16x8 aq[2][2];
#pragma unroll
    for (int tile = 0; tile < 2; ++tile) { const int t0 = qb * 64 + wave * 8 + tile * 4;
        const size_t qoff = (size_t)(b * SEQ + t0 + (r16 & 3)) * 1024 + (g * 4 + (r16 >> 2)) * 64 + q4 * 8;
        aq[tile][0] = *(const bf16x8*)(Q + qoff); aq[tile][1] = *(const bf16x8*)(Q + qoff + 32); }
    f32x4 os[2][4]; float ls[2][4];
#pragma unroll
    for (int tile = 0; tile < 2; ++tile)
#pragma unroll
        for (int i = 0; i < 4; ++i) { os[tile][i] = z4; ls[tile][i] = 0.f; }
    const int srow = tid >> 3, sch = tid & 7, soff = srow * 72 + sch * 8;
    const unsigned kgo = (unsigned)(srow * 64 + sch * 8) * 2u, vgo = (unsigned)(srow * SEQ + sch * 8) * 2u;
#define NSA_LD1(jj) do { kr = *(const bf16x8*)((const char*)Kt + (size_t)(jj) * 8192 + kgo); vr = *(const bf16x8*)((const char*)Vt + (jj) * 128 + vgo); } while (0)
#define NSA_ST1(st_, half_) do { LAS bf16_t* nx_ = stage + (st_) * 18432 + (half_) * 9216 + soff; *(LAS bf16x8*)nx_ = kr; *(LAS bf16x8*)(nx_ + 4608) = vr; } while (0)
    bf16x8 kr, vr;
    NSA_LD1(j0); NSA_ST1(0, 0);
    if (j0 + 1 <= qb) { NSA_LD1(j0 + 1); NSA_ST1(0, 1); }
    __syncthreads();
    for (int jA = j0, pp = 0; jA <= qb; jA += 2, pp ^= 1) {
      for (int sub = 0; sub < 2; ++sub) {
        const int j = jA + sub; if (j > qb) break;
        const bool pre = j + 2 <= qb;
        if (pre) NSA_LD1(j + 2);
        const LAS bf16_t* Ks = stage + pp * 18432 + sub * 9216; const LAS bf16_t* Vs = Ks + 4608;
        const bool far = MODE == 0 && (qb - j >= 17);
#pragma unroll
        for (int tile = 0; tile < 2; ++tile) {
            const int tl0 = wave * 8 + tile * 4, t0 = qb * 64 + tl0;
            unsigned mb[4] = {1u, 1u, 1u, 1u};
            if (MODE == 0) {
#pragma unroll
                for (int i = 0; i < 4; ++i) mb[i] = (masks[(tl0 + i) * 4 + (j >> 5)] >> (j & 31)) & 1u; }
            if (MODE == 1 || __builtin_amdgcn_readfirstlane((int)(mb[0] | mb[1] | mb[2] | mb[3]))) {
                f32x4 sc[4];
#pragma unroll
                for (int cc = 0; cc < 4; ++cc) { const LAS bf16_t* kp = Ks + (cc * 16 + r16) * 72 + q4 * 8;
                    sc[cc] = MFMA16(aq[tile][0], *(const LAS bf16x8*)kp, z4); sc[cc] = MFMA16(aq[tile][1], *(const LAS bf16x8*)(kp + 32), sc[cc]); }
                if (far) {
#pragma unroll
                    for (int cc = 0; cc < 4; ++cc)
#pragma unroll
                        for (int i = 0; i < 4; ++i) { const float p = mb[i] ? ex2(sc[cc][i] + bfar) : 0.f; ls[tile][i] += p; Pb[(4 * q4 + i) * 72 + cc * 16 + r16] = tobf(p); }
                } else {
#pragma unroll
                    for (int cc = 0; cc < 4; ++cc) { const int pos = j * 64 + cc * 16 + r16;
#pragma unroll
                        for (int i = 0; i < 4; ++i) { const int dist = t0 + i - pos; const bool ok = MODE ? ((unsigned)dist < 512u) : (dist >= 0 && mb[i]);
                            const float p = ok ? ex2(sc[cc][i] + bt[clampd(dist)]) : 0.f; ls[tile][i] += p; Pb[(4 * q4 + i) * 72 + cc * 16 + r16] = tobf(p); } }
                }
                CBAR();
#pragma unroll
                for (int ks = 0; ks < 2; ++ks) { const bf16x8 aP = *(const LAS bf16x8*)(Pb + r16 * 72 + ks * 32 + q4 * 8);
#pragma unroll
                    for (int nt = 0; nt < 4; ++nt) os[tile][nt] = MFMA16(aP, *(const LAS bf16x8*)(Vs + (nt * 16 + r16) * 72 + ks * 32 + q4 * 8), os[tile][nt]); }
                CBAR();
            }
        }
        if (pre) NSA_ST1(pp ^ 1, sub);
      }
        __syncthreads();
    }
#undef NSA_LD1
#undef NSA_ST1
#pragma unroll
    for (int tile = 0; tile < 2; ++tile) { const int t0 = qb * 64 + wave * 8 + tile * 4;
#pragma unroll
        for (int tt = 0; tt < 4; ++tt) { const float gs = GN[(size_t)(b * SEQ + t0 + tt) * 48 + (g * 4 + q4) * 3 + (MODE ? 2 : 1)] / red16(ls[tile][tt]);
            bf16_t* op = ONSA + (size_t)(b * SEQ + t0 + tt) * 1024 + (g * 4 + q4) * 64 + r16;
#pragma unroll
            for (int nt = 0; nt < 4; ++nt) op[nt * 16] = tobf(bflo((unsigned)op[nt * 16]) + gs * os[tile][nt][tt]); } }
}

__device__ __forceinline__ int t5_bucket(int d) {
    if (d < 16) return d;
    if (d >= 1024) return 31;
    int k = 0;
    k += d >= 21; k += d >= 27; k += d >= 35; k += d >= 46; k += d >= 59; k += d >= 77; k += d >= 99; k += d >= 128;
    k += d >= 166; k += d >= 216; k += d >= 280; k += d >= 363; k += d >= 470; k += d >= 609; k += d >= 790;
    return 16 + k;
}
__device__ __forceinline__ void nsa_phase(LAS unsigned char* lds, const bf16_t* Q, const bf16_t* KV, const bf16_t* KCMP, const bf16_t* VCMPT, const float* GN, const float* rel_bias, bf16_t* ONSA,
                                          int tid, int lane, int wave) {
    LAS float* btab = (LAS float*)lds;
    LAS bf16_t* Pb = (LAS bf16_t*)(lds + 16448 + wave * 2304);
    LAS bf16_t* qfw = (LAS bf16_t*)(lds + 34880 + wave * 2048);
    LAS int* selall = (LAS int*)(lds + 51264);
    LAS unsigned* masks = (LAS unsigned*)(lds + 55360);
    LAS float* psum = (LAS float*)(lds + 56384 + wave * 8192);
    LAS bf16_t* stage = (LAS bf16_t*)(lds + 56384);
    for (int i = lane; i < 576; i += 64) ((LAS unsigned*)Pb)[i] = 0u;
    for (int vb = blockIdx.x; vb < 256; vb += gridDim.x) {
        const int xcd = vb & 7, idx = vb >> 3;
        for (int pass = 0; pass < 2; ++pass) {
            const int bg = xcd + 8 * pass, g = bg & 3;
            __syncthreads();
            for (int i2 = tid; i2 < 4 * 1025; i2 += NTHREADS) { const int hh = i2 / 1025, dd = i2 - hh * 1025; btab[hh * 1028 + dd] = 1.44269504089f * rel_bias[t5_bucket(dd) * 16 + g * 4 + hh]; }
            __syncthreads();
            for (int kk = 0; kk < 4; ++kk) {
                const int qb = (kk & 1) ? (32 * kk + 31 - idx) : (32 * kk + idx);
                nsa_quad_pre(bg, qb * 16 + wave * 2, Q, KV, KCMP, VCMPT, GN, ONSA, btab, Pb, psum, selall + (wave * 2) * 64, qfw, lane);
                nsa_quad_pre(bg, qb * 16 + wave * 2 + 1, Q, KV, KCMP, VCMPT, GN, ONSA, btab, Pb, psum, selall + (wave * 2 + 1) * 64, qfw, lane);
                __syncthreads();
                nsa_block_loop<0>(bg, qb, Q, KV, GN, ONSA, btab, Pb, selall, masks, stage, tid, lane, wave);
                nsa_block_loop<1>(bg, qb, Q, KV, GN, ONSA, btab, Pb, selall, masks, stage, tid, lane, wave);
            }
        }
    }
    __syncthreads();
}

#define XB_TMO      128
#define XB_XCNT(j)  (256  + 64 * (j))
#define XB_XSUB(j)  (1280 + 64 * (j))
#define XB_XGEN(j)  (2304 + 64 * (j))
#define XB_TOP      3328
#define XB_TOPGEN   3392
#define XCD_BAR_WORDS 3456
#define XB_SPIN_CAP (1u << 18)

__device__ __forceinline__ unsigned xb_ld(unsigned* p)              { return __hip_atomic_load(p, __ATOMIC_RELAXED, __HIP_MEMORY_SCOPE_AGENT); }
__device__ __forceinline__ unsigned xb_add(unsigned* p, unsigned v) { return __hip_atomic_fetch_add(p, v, __ATOMIC_RELAXED, __HIP_MEMORY_SCOPE_AGENT); }
__device__ __forceinline__ unsigned xb_xcc_id() { return (unsigned)__builtin_amdgcn_s_getreg((3 << 11) | 20) & 0xFu; }
#define XB_SPIN(cond, bar) do { unsigned _sp = 0; while (cond) { __builtin_amdgcn_s_sleep(1); \
    if ((++_sp & 255u) == 0u) { if (xb_ld(&(bar)[XB_TMO])) break; if (_sp > XB_SPIN_CAP) { atomicAdd(&(bar)[XB_TMO], 1u); break; } } } } while (0)

struct XcdBarrier {
    unsigned* bar; unsigned x;
    volatile LAS unsigned* st;
};

__device__ __forceinline__ XcdBarrier xcd_barrier_post(unsigned* bar, volatile LAS unsigned* st) {
    XcdBarrier b; b.bar = bar; b.x = xb_xcc_id(); b.st = st;
    if (threadIdx.x == 0) (void)xb_add(&bar[XB_XCNT(b.x)], 1u);
    return b;
}
__device__ __forceinline__ void xcd_barrier_complete(unsigned* bar, unsigned x, unsigned& nloc, unsigned& nx) {
    const unsigned G = gridDim.x * gridDim.y * gridDim.z;
    unsigned sum, cnt, mine, sp = 0u;
    for (;;) {
        sum = 0u; cnt = 0u; mine = 0u;
#pragma unroll
        for (unsigned j = 0; j < 16; ++j) { const unsigned c = xb_ld(&bar[XB_XCNT(j)]); sum += c; cnt += (c > 0u) ? 1u : 0u; mine = (j == x) ? c : mine; }
        if (sum == G) break;
        __builtin_amdgcn_s_sleep(1);
        if ((++sp & 255u) == 0u) { if (xb_ld(&bar[XB_TMO])) break; if (sp > XB_SPIN_CAP) { atomicAdd(&bar[XB_TMO], 1u); break; } }
    }
    nloc = mine > 0u ? mine : 1u; nx = cnt > 0u ? cnt : 1u;
}

__device__ __forceinline__ void xcd_barrier(const XcdBarrier& b) {
    asm volatile("s_waitcnt vmcnt(0)" ::: "memory");
    __syncthreads();
    if (threadIdx.x == 0) {
        unsigned* bar = b.bar;
        __builtin_amdgcn_s_waitcnt(0);
        unsigned nloc = b.st[0], nx = b.st[1];
        if (nloc == 0u) { xcd_barrier_complete(bar, b.x, nloc, nx); b.st[0] = nloc; b.st[1] = nx; }
        const unsigned old = xb_add(&bar[XB_XSUB(b.x)], 1u);
        const unsigned gen = old / nloc;
        if (old + 1u == (gen + 1u) * nloc) {
            __builtin_amdgcn_fence(__ATOMIC_RELEASE, "agent");
            asm volatile("s_waitcnt vmcnt(0)" ::: "memory");
            const unsigned og = xb_add(&bar[XB_TOP], 1u);
            const unsigned tg = og / nx;
            if (og + 1u == (tg + 1u) * nx) xb_add(&bar[XB_TOPGEN], 1u);
            else XB_SPIN(xb_ld(&bar[XB_TOPGEN]) == tg, bar);
            __builtin_amdgcn_fence(__ATOMIC_ACQUIRE, "agent");
            xb_add(&bar[XB_XGEN(b.x)], 1u);
            asm volatile("s_waitcnt vmcnt(0)" ::: "memory");
        } else {
            XB_SPIN(xb_ld(&bar[XB_XGEN(b.x)]) == gen, bar);
            __builtin_amdgcn_fence(__ATOMIC_ACQUIRE, "agent");
            asm volatile("s_waitcnt vmcnt(0)" ::: "memory");
        }
    }
    __syncthreads();
}


__global__ void __launch_bounds__(NTHREADS, 2) fwd_kernel(Params P) {
    extern __shared__ __attribute__((aligned(16))) unsigned char lds_raw[];
    LAS unsigned char* lds = (LAS unsigned char*)lds_raw;
    cg::grid_group grid = cg::this_grid();
    int tid = threadIdx.x, lane = tid & 63, wave = __builtin_amdgcn_readfirstlane(tid >> 6);
    const int G = gridDim.x, NGW = G * 8; int gw = blockIdx.x * 8 + wave;
#define REIDS() do { tid = threadIdx.x; asm volatile("" : "+v"(tid)); lane = tid & 63; wave = __builtin_amdgcn_readfirstlane(tid >> 6); gw = blockIdx.x * 8 + wave; } while (0)
    ((LAS int*)(lds + 145408))[tid] = tid; if (tid < 2) ((LAS unsigned*)(lds + 131072))[tid] = 0u; __syncthreads();
    const XcdBarrier xbar = xcd_barrier_post((unsigned*)(P.ws + WS_BAR), (volatile LAS unsigned*)(lds + 131072));
    unsigned char* ws = P.ws;
    bf16_t* W1GU = (bf16_t*)(ws + WS_W1GU); bf16_t* W1D = (bf16_t*)(ws + WS_W1D); bf16_t* W2GU = (bf16_t*)(ws + WS_W2GU); bf16_t* W2D = (bf16_t*)(ws + WS_W2D);
    bf16_t* WIN = (bf16_t*)(ws + WS_WIN); bf16_t* WGLU = (bf16_t*)(ws + WS_WGLU); bf16_t* WO = (bf16_t*)(ws + WS_WO); bf16_t* WOUT = (bf16_t*)(ws + WS_WOUT);
    bf16_t* CKW1 = (bf16_t*)(ws + WS_CKW1); bf16_t* CVW1 = (bf16_t*)(ws + WS_CVW1);
    bf16_t* XN = (bf16_t*)(ws + WS_XN); bf16_t* ACT = (bf16_t*)(ws + WS_ACT); bf16_t* FB = (bf16_t*)(ws + WS_F); bf16_t* KV = (bf16_t*)(ws + WS_KV);
    bf16_t* YSSM = XN; bf16_t* ONSA = XN + (size_t)MTOK * 1024;
    bf16_t* GA = ACT; bf16_t* GB = ACT + (size_t)MTOK * 2048; bf16_t* USSM = ACT + (size_t)MTOK * 4096; bf16_t* MIXED = ACT;
    bf16_t* QB = FB; bf16_t* MERGED = FB;
    bf16_t* H1K = (bf16_t*)(ws + WS_H1K); bf16_t* H1V = (bf16_t*)(ws + WS_H1V); bf16_t* KCMP = (bf16_t*)(ws + WS_KCMP); bf16_t* VCMPT = (bf16_t*)(ws + WS_VCMPT);
    float* GN = (float*)(ws + WS_GN); float* S5A = (float*)(ws + WS_S5A); float* S5B = (float*)(ws + WS_S5B); float* CB = (float*)(ws + WS_CB);
    const float* x = P.in[0]; float* out = P.out;

    {
        LAS float* scr = (LAS float*)(lds + wave * 16384);
        constexpr int I_FF = 5632, I_IN = 7936, I_GL = 1024, I_OUT = 2048, I_C = 256;
        constexpr int NITEMS = 6 * I_FF + I_IN + 3 * I_GL + I_OUT + 2 * I_C;
        for (int it = gw; it < NITEMS; it += NGW) {
            int r = it;
            if (r < I_FF) { tr_job(P.in[2], DFF, DM, 176, W1GU, r, 1, scr, lane); continue; } r -= I_FF;
            if (r < I_FF) { tr_job(P.in[3], DFF, DM, 176, W1GU, r, 2, scr, lane); continue; } r -= I_FF;
            if (r < I_FF) { tr_job(P.in[4], DM, DFF, 64, W1D, r, 0, scr, lane); continue; } r -= I_FF;
            if (r < I_FF) { tr_job(P.in[27], DFF, DM, 176, W2GU, r, 1, scr, lane); continue; } r -= I_FF;
            if (r < I_FF) { tr_job(P.in[28], DFF, DM, 176, W2GU, r, 2, scr, lane); continue; } r -= I_FF;
            if (r < I_FF) { tr_job(P.in[29], DM, DFF, 64, W2D, r, 0, scr, lane); continue; } r -= I_FF;
            if (r < I_IN) { tr_job(P.in[7], 7728, DM, 248, WIN, r, 3, scr, lane); continue; } r -= I_IN;
            if (r < I_GL) { tr_job(P.in[16], 2048, 1024, 64, WGLU, r, 1, scr, lane); continue; } r -= I_GL;
            if (r < I_GL) { tr_job(P.in[17], 2048, 1024, 64, WGLU, r, 2, scr, lane); continue; } r -= I_GL;
            if (r < I_GL) { tr_job(P.in[23], 2048, 1024, 64, WO, r, 0, scr, lane); continue; } r -= I_GL;
            if (r < I_OUT) { tr_job(P.in[24], 2048, 2048, 64, WOUT, r, 0, scr, lane); continue; } r -= I_OUT;
            if (r < I_C) { tr_job(P.in[19], 256, 2048, 8, CKW1, r, 0, scr, lane); continue; } r -= I_C;
            tr_job(P.in[21], 256, 2048, 8, CVW1, r, 0, scr, lane);
        }
        for (int m = gw; m < MTOK; m += NGW) norm_row(x + (size_t)m * DM, P.in[1], XN + (size_t)m * DM, lane);
        const int gid = blockIdx.x * NTHREADS + tid;
        if (gid < 4096) {
            const int g = gid >> 6;
            const float dt = expf(P.in[10][g]); const float lre = fminf(P.in[8][gid], -1e-4f), lim = P.in[9][gid];
            const float mag = expf(lre * dt);
            double th = (double)lim * (double)dt; th -= 6.283185307179586476925 * rint(th * 0.15915494309189533577); const double t2 = th * th;
            double sn = 1.0, cs = 1.0;
            { double term = 1.0; double s = 0.0, c = 0.0; for (int k = 0; k < 14; ++k) { c += term; term *= th / (double)(2 * k + 1); s += term; term *= -th / (double)(2 * k + 2); } sn = s; cs = c; (void)t2; }
            const float are = mag * (float)cs, aim = mag * (float)sn;
            const float den = lre * lre + lim * lim, nre = are - 1.f, nim = aim;
            const float cre = (nre * lre + nim * lim) / den, cim = (nim * lre - nre * lim) / den;
            S5A[gid * 2] = are; S5A[gid * 2 + 1] = aim;
            for (int c = 0; c < 16; ++c) { const float br = P.in[11][gid * 16 + c], bi = P.in[12][gid * 16 + c]; S5B[(size_t)gid * 32 + c] = cre * br - cim * bi; S5B[(size_t)gid * 32 + 16 + c] = cre * bi + cim * br; }
        }
    }
    grid.sync(); REIDS();
    { pg8::Gemm gm{XN, W1GU, MTOK, 2 * DFF, DM, DM}; pg8::StaticOrder S; S.init(MTOK, 2 * DFF, G, (int)blockIdx.x); EpiSwiGLU E{ACT, DFF}; pg8::gemm_phase<true>(lds, gm, S, E); }
    xcd_barrier(xbar); REIDS();
    { pg8::Gemm gm{ACT, W1D, MTOK, DM, DFF, DFF}; pg8::StaticOrder S; S.init(MTOK, DM, G, (int)blockIdx.x); EpiStore E{FB, DM}; pg8::gemm_phase<true>(lds, gm, S, E); }
    xcd_barrier(xbar); REIDS();
    for (int m = gw; m < MTOK; m += NGW) rowwise_row(FB + (size_t)m * DM, x + (size_t)m * DM, 0.5f, P.in[5], out + (size_t)m * DM, P.in[6], XN + (size_t)m * DM, lane);
    if (gw < 512) { const int n = gw & 255; const bf16_t* wrow = (gw >> 8 ? CVW1 : CKW1) + (size_t)n * 2048; float s = 0.f;
#pragma unroll
        for (int j = 0; j < 4; ++j) { const int c = 512 * j + 8 * lane; f32x4 w0, w1; unpack8(*(const u32x4*)(wrow + c), w0, w1); const f32x4 p0 = *(const f32x4*)(P.in[18] + c), p1 = *(const f32x4*)(P.in[18] + c + 4);
#pragma unroll
            for (int i = 0; i < 4; ++i) s += w0[i] * p0[i] + w1[i] * p1[i]; }
        s = wave_sum(s); if (lane == 0) CB[gw] = s; }
#if PROGRAM_END > 3
    xcd_barrier(xbar); REIDS();
    { pg8::Gemm gm{XN, WIN, MTOK, NIN, DM, DM}; pg8::StaticOrder S; S.init(MTOK, NIN, G, (int)blockIdx.x); EpiIn E{USSM, QB, KV, GA, GB, GN}; pg8::gemm_phase<false>(lds, gm, S, E); }
    xcd_barrier(xbar); REIDS();
    { pg8::Gemm gm{KV, CKW1, 8192, 256, 2048, 1024}; pg8::StaticOrder S; S.init(8192, 256, G, (int)blockIdx.x); EpiCmp E{H1K, CB}; pg8::gemm_phase<false>(lds, gm, S, E); }
    { pg8::Gemm gm{KV + (size_t)MTOK * 256, CVW1, 8192, 256, 2048, 1024}; pg8::StaticOrder S; S.init(8192, 256, G, (int)((blockIdx.x + G - 32) % G)); EpiCmp E{H1V, CB + 256}; pg8::gemm_phase<false>(lds, gm, S, E); }
    s5_phase(lds, USSM, S5A, S5B, P.in[13], P.in[14], P.in[15], YSSM, tid, lane, wave);
    xcd_barrier(xbar); REIDS();
    cmp2_phase(lds, H1K, H1V, P.in[20], P.in[22], KCMP, VCMPT, tid);
    xcd_barrier(xbar); REIDS();
    nsa_phase(lds, QB, KV, KCMP, VCMPT, GN, P.in[31], ONSA, tid, lane, wave);
    xcd_barrier(xbar); REIDS();
    { pg8::Gemm gm{YSSM, WGLU, MTOK, 4096, 1024, 1024}; pg8::StaticOrder S; S.init(MTOK, 4096, G, (int)blockIdx.x); EpiGLU E{MERGED, GA}; pg8::gemm_phase<true>(lds, gm, S, E); }
    xcd_barrier(xbar); REIDS();
    { pg8::Gemm gm{ONSA, WO, MTOK, 2048, 1024, 1024}; pg8::StaticOrder S; S.init(MTOK, 2048, G, (int)blockIdx.x); EpiWo E{MERGED, GB}; pg8::gemm_phase<true>(lds, gm, S, E); }
    xcd_barrier(xbar); REIDS();
    { pg8::Gemm gm{MERGED, WOUT, MTOK, 2048, 2048, 2048}; pg8::StaticOrder S; S.init(MTOK, 2048, G, (int)blockIdx.x); EpiStore E{MIXED, DM}; pg8::gemm_phase<true>(lds, gm, S, E); }
    xcd_barrier(xbar); REIDS();
    for (int m = gw; m < MTOK; m += NGW) rowwise_row(MIXED + (size_t)m * DM, out + (size_t)m * DM, 1.0f, P.in[25], out + (size_t)m * DM, P.in[26], XN + (size_t)m * DM, lane);
#endif
#if PROGRAM_END > 11
    xcd_barrier(xbar); REIDS();
    { pg8::Gemm gm{XN, W2GU, MTOK, 2 * DFF, DM, DM}; pg8::StaticOrder S; S.init(MTOK, 2 * DFF, G, (int)blockIdx.x); EpiSwiGLU E{ACT, DFF}; pg8::gemm_phase<true>(lds, gm, S, E); }
    xcd_barrier(xbar); REIDS();
    { pg8::Gemm gm{ACT, W2D, MTOK, DM, DFF, DFF}; pg8::StaticOrder S; S.init(MTOK, DM, G, (int)blockIdx.x); EpiStore E{FB, DM}; pg8::gemm_phase<true>(lds, gm, S, E); }
    xcd_barrier(xbar); REIDS();
    for (int m = gw; m < MTOK; m += NGW) rowwise_row(FB + (size_t)m * DM, out + (size_t)m * DM, 0.5f, P.in[30], out + (size_t)m * DM, nullptr, nullptr, lane);
#endif
}

extern "C" void kernel_launch(void* const* d_in, const int* in_sizes, int n_in, void* d_out, int out_size, void* d_ws, size_t ws_size, hipStream_t stream) {
    static int grid_blocks = 0;
    if (!grid_blocks) {
        int dev = 0, cus = 0, per_cu = 0;
        hipGetDevice(&dev);
        hipDeviceGetAttribute(&cus, hipDeviceAttributeMultiprocessorCount, dev);
        hipFuncSetAttribute((const void*)fwd_kernel, hipFuncAttributeMaxDynamicSharedMemorySize, LDS_BYTES);
        hipOccupancyMaxActiveBlocksPerMultiprocessor(&per_cu, (const void*)fwd_kernel, NTHREADS, LDS_BYTES);
        if (per_cu < 1) per_cu = 1;
        grid_blocks = cus * per_cu; if (grid_blocks > 256) grid_blocks = 256;
        if (ws_size < WS_END || n_in != 32) fprintf(stderr, "kernel_launch: unexpected ws_size %zu (need %zu) or n_in %d\n", ws_size, (size_t)WS_END, n_in);
    }
    hipMemsetAsync((char*)d_ws + WS_BAR, 0, 3456 * 4, stream);
    Params p{};
    for (int i = 0; i < 32; ++i) p.in[i] = (const float*)d_in[i];
    p.out = (float*)d_out; p.ws = (unsigned char*)d_ws;
    void* args[] = {&p};
    hipError_t e = hipLaunchCooperativeKernel((const void*)fwd_kernel, dim3(grid_blocks), dim3(NTHREADS), args, LDS_BYTES, stream);
    if (e != hipSuccess) fprintf(stderr, "cooperative launch failed: %s (grid %d)\n", hipGetErrorString(e), grid_blocks);
}
```
